# Optimizing an MI355X kernel written in HIP

```python
import math
import jax
import jax.numpy as jnp
from jax import lax
import numpy as np

D_MODEL = 1024
BATCH = 4
SEQ = 4096
DEPTH = 4

GRID_W = 64
CTX_LEN = 256
N_GROUPS = 4
D_MIX = D_MODEL
GROUP_W = D_MIX // N_GROUPS
HEAD_DIM = 64
GROUP_HEADS = GROUP_W // HEAD_DIM
D_FF = 4 * D_MODEL
CHUNK = 64
RWKV_DECAY_RANK = 64
RWKV_AAA_RANK = 64
RWKV_GATE_RANK = 128
GDN_CONV_W = 5
LN_EPS = 1e-5
RWKV_GN_EPS = 64e-5
NORM_EPS = 1e-6
DEEPNORM_ALPHA = (2.0 * DEPTH) ** 0.25
DEEPNORM_BETA = (8.0 * DEPTH) ** -0.25
A_COLS = (GROUP_W, GROUP_W, 2 * GROUP_W, GROUP_W)
B_COLS = (GROUP_W, GROUP_W, GROUP_W, 2 * RWKV_DECAY_RANK, 2 * RWKV_AAA_RANK, RWKV_GATE_RANK)
C_COLS = (3 * GROUP_W, 2 * GROUP_HEADS, 2 * GROUP_HEADS, GROUP_W)
D_COLS = (3 * GROUP_W, 2 * GROUP_HEADS, 2 * GROUP_HEADS, GROUP_W)
GROUP_COLS = (sum(A_COLS), sum(B_COLS), sum(C_COLS), sum(D_COLS))
D_IN = sum(GROUP_COLS)

kernel_name = "hybrid_parallel_heads_flow_block"


def split_cols(t, widths):
    offsets = [int(o) for o in np.cumsum(widths)[:-1]]
    return jnp.split(t, offsets, axis=-1)


def layer_norm(t, g, b):
    tf = t.astype(jnp.float32)
    mu = jnp.mean(tf, -1, keepdims=True)
    var = jnp.mean(jnp.square(tf - mu), -1, keepdims=True)
    return ((tf - mu) * lax.rsqrt(var + LN_EPS) * g + b).astype(t.dtype)


def modulate(t, shift, scale):
    return t * (1 + scale) + shift


def squared_relu_mlp(h, w1, w2):
    return jnp.square(jax.nn.relu(h @ w1)) @ w2


def to_col_major(t):
    bsz, n, ch = t.shape
    rows = n // GRID_W
    return t.reshape(bsz, rows, GRID_W, ch).transpose(0, 2, 1, 3).reshape(bsz, n, ch)


def from_col_major(t):
    bsz, n, ch = t.shape
    rows = n // GRID_W
    return t.reshape(bsz, GRID_W, rows, ch).transpose(0, 2, 1, 3).reshape(bsz, n, ch)


def split_heads(t):
    return t.reshape(t.shape[:-1] + (GROUP_HEADS, HEAD_DIM))


def heads(t):
    return jnp.swapaxes(split_heads(t), -2, -3)


def unheads(t):
    t = jnp.swapaxes(t, -2, -3)
    return t.reshape(t.shape[:-2] + (GROUP_W,))


def head_scalars(t):
    return jnp.swapaxes(t, -1, -2)


def l2_normalize(t):
    return t * lax.rsqrt(jnp.sum(t * t, -1, keepdims=True) + 1e-12)


def head_l2(t):
    return l2_normalize(split_heads(t)).reshape(t.shape)


def head_rms_norm(t, g):
    th = split_heads(t)
    th = th * lax.rsqrt(jnp.mean(th * th, -1, keepdims=True) + NORM_EPS)
    return th.reshape(t.shape) * g


def group_norm(t, g, b):
    mu = jnp.mean(t, -1, keepdims=True)
    var = jnp.mean(jnp.square(t - mu), -1, keepdims=True)
    tn = (t - mu) * lax.rsqrt(var + RWKV_GN_EPS)
    return tn.reshape(t.shape[:-2] + (GROUP_W,)) * g + b


def dir_shared(t):
    return jnp.stack([t, jnp.flip(t, axis=1)])


def dir_own(t):
    fwd, bwd = jnp.split(t, 2, axis=-1)
    return jnp.stack([fwd, jnp.flip(bwd, axis=1)])


def dir_sum(t):
    return t[0] + jnp.flip(t[1], axis=1)


def to_chunks(t, axis):
    n = t.shape[axis]
    t = t.reshape(t.shape[:axis] + (n // CHUNK, CHUNK) + t.shape[axis + 1:])
    return jnp.moveaxis(t, axis, 0)


def from_chunks(t):
    t = jnp.moveaxis(t, 0, -3)
    return t.reshape(t.shape[:-3] + (t.shape[-3] * t.shape[-2], t.shape[-1]))


def token_shift(t, mu):
    pad = jnp.pad(t, ((0, 0), (1, 1), (0, 0)))
    return t + mu * (0.5 * (pad[:, :-2] + pad[:, 2:]) - t)


def depthwise_conv(t, w):
    k = w.shape[0]
    return lax.conv_general_dilated(t, w.astype(t.dtype)[:, None, :], window_strides=(1,),
                                    padding=[(k // 2, k // 2)],
                                    dimension_numbers=('NWC', 'WIO', 'NWC'),
                                    feature_group_count=t.shape[-1])


def chunk_gla(q, k, v, log_f, s0):
    causal = jnp.tril(jnp.ones((CHUNK, CHUNK), bool))[:, :, None]

    def step(s, inp):
        qc, kc, vc, lfc = inp
        cum = jnp.cumsum(lfc, axis=-2)
        rel = cum[..., :, None, :] - cum[..., None, :, :]
        decay = jnp.exp(jnp.where(causal, rel, -jnp.inf))
        scores = jnp.einsum('...ik,...ijk,...jk->...ij', qc, decay, kc)
        o = (jnp.einsum('...ik,...kv->...iv', qc * jnp.exp(cum), s)
             + jnp.einsum('...ij,...jv->...iv', scores, vc))
        last = cum[..., -1:, :]
        s = (jnp.exp(last[..., 0, :])[..., :, None] * s
             + jnp.einsum('...jk,...jv->...kv', kc * jnp.exp(last - cum), vc))
        return s, o

    xs = tuple(to_chunks(t, t.ndim - 2) for t in (q, k, v, log_f))
    s, o = lax.scan(step, s0, xs)
    return from_chunks(o), s


def chunk_gated_delta(q, k, v, beta, log_a, s0):
    eye = jnp.eye(CHUNK, dtype=jnp.float32)
    incl = jnp.tril(jnp.ones((CHUNK, CHUNK), bool))
    strict = jnp.tril(jnp.ones((CHUNK, CHUNK), bool), -1)

    def step(s, inp):
        qc, kc, vc, bc, lac = inp
        cum = jnp.cumsum(lac, axis=-1)
        gam = jnp.exp(jnp.where(incl, cum[..., :, None] - cum[..., None, :], -jnp.inf))
        kb = kc * bc[..., None]
        m = eye + jnp.where(strict, jnp.einsum('...id,...jd->...ij', kb, kc) * gam, 0.0)
        rhs = jnp.concatenate([vc * bc[..., None], kb * jnp.exp(cum)[..., None]], axis=-1)
        sol = lax.linalg.triangular_solve(m, rhs, left_side=True, lower=True, unit_diagonal=True)
        u, w = sol[..., :HEAD_DIM], sol[..., HEAD_DIM:]
        v_new = u - jnp.einsum('...ik,...kv->...iv', w, s)
        attn = jnp.einsum('...id,...jd->...ij', qc, kc) * gam
        o = (jnp.einsum('...ik,...kv->...iv', qc * jnp.exp(cum)[..., None], s)
             + jnp.einsum('...ij,...jv->...iv', attn, v_new))
        last = cum[..., -1:]
        s = (jnp.exp(last)[..., None] * s
             + jnp.einsum('...jk,...jv->...kv', kc * jnp.exp(last - cum)[..., None], v_new))
        return s, o

    xs = (to_chunks(q, q.ndim - 2), to_chunks(k, k.ndim - 2), to_chunks(v, v.ndim - 2),
          to_chunks(beta, beta.ndim - 1), to_chunks(log_a, log_a.ndim - 1))
    s, o = lax.scan(step, s0, xs)
    return from_chunks(o), s


def chunk_mlstm(q, k, v, log_i, log_f, state):
    incl = jnp.tril(jnp.ones((CHUNK, CHUNK), bool))

    def step(carry, inp):
        cmat, nvec, m = carry
        qc, kc, vc, lic, lfc = inp
        b = jnp.cumsum(lfc, axis=-1)
        dlog = jnp.where(incl, b[..., :, None] - b[..., None, :] + lic[..., None, :], -jnp.inf)
        inter = b + m[..., None]
        m_i = jnp.maximum(inter, jnp.max(dlog, -1))
        dw = jnp.exp(dlog - m_i[..., None])
        iw = jnp.exp(inter - m_i)
        sc = jnp.einsum('...id,...jd->...ij', qc, kc) * dw
        num = (iw[..., None] * jnp.einsum('...ik,...kv->...iv', qc, cmat)
               + jnp.einsum('...ij,...jv->...iv', sc, vc))
        den = iw * jnp.einsum('...ik,...k->...i', qc, nvec) + jnp.sum(sc, -1)
        h = num / jnp.maximum(jnp.abs(den), jnp.exp(-m_i))[..., None]
        bl = b[..., -1]
        src = bl[..., None] - b + lic
        m_new = jnp.maximum(bl + m, jnp.max(src, -1))
        carry_w = jnp.exp(bl + m - m_new)
        wj = jnp.exp(src - m_new[..., None])
        cmat = carry_w[..., None, None] * cmat + jnp.einsum('...jk,...jv->...kv', kc * wj[..., None], vc)
        nvec = carry_w[..., None] * nvec + jnp.einsum('...jk,...j->...k', kc, wj)
        return (cmat, nvec, m_new), h

    xs = (to_chunks(q, q.ndim - 2), to_chunks(k, k.ndim - 2), to_chunks(v, v.ndim - 2),
          to_chunks(log_i, log_i.ndim - 1), to_chunks(log_f, log_f.ndim - 1))
    state, h = lax.scan(step, state, xs)
    return from_chunks(h), state


def rwkv7_scan(r, decay, k, v, kk, a, s0):
    def step(s, inp):
        rt, wt, kt, vt, kkt, at = inp
        sa = jnp.einsum('...vk,...k->...v', s, kkt)
        s = (s * wt[..., None, :] - sa[..., :, None] * (kkt * at)[..., None, :]
             + vt[..., :, None] * kt[..., None, :])
        return s, jnp.einsum('...vk,...k->...v', s, rt)

    xs = tuple(jnp.moveaxis(t, 2, 0) for t in (r, decay, k, v, kk, a))
    s, o = lax.scan(step, s0, xs)
    return jnp.moveaxis(o, 0, 2), s


def hgrn2_mixer(cols_ctx, cols_lat, gamma, layer, norm_g):
    lb_cum = jnp.cumsum(jax.nn.softmax(gamma.astype(jnp.float32), axis=0), axis=0)
    lb = (lb_cum[layer] - lb_cum[0])[:, None, None, :]

    def prep(cols):
        q, i, f, g = split_cols(cols.astype(jnp.float32), A_COLS)
        log_f = jnp.logaddexp(jnp.log(lb), jnp.log1p(-lb) + jax.nn.log_sigmoid(dir_own(f)))
        k = -jnp.expm1(log_f)
        return (heads(dir_shared(q)), heads(k), heads(dir_shared(i)), heads(log_f)), g

    def finish(o, g):
        return head_rms_norm(dir_sum(unheads(o)), norm_g) * jax.nn.silu(g)

    xs_ctx, g_ctx = prep(cols_ctx)
    s0 = jnp.zeros((2, cols_ctx.shape[0], GROUP_HEADS, HEAD_DIM, HEAD_DIM), jnp.float32)
    o_ctx, s_ctx = chunk_gla(*xs_ctx, s0)
    xs_lat, g_lat = prep(cols_lat)
    o_lat, _ = chunk_gla(*xs_lat, s_ctx)
    return finish(o_ctx, g_ctx), finish(o_lat, g_lat)


def rwkv7_mixer(cols_ctx, cols_lat, mu, w0, w2, a0, a2, g2, k_k, k_a, r_k, ln_g, ln_b):
    def prep(cols):
        cols = token_shift(cols.astype(jnp.float32), mu)
        r, k, v, wd, ad, gd = split_cols(cols, B_COLS)
        w = -jax.nn.softplus(-(w0[:, None, None, :] + jnp.einsum('dbnr,drc->dbnc', jnp.tanh(dir_own(wd)), w2))) - 0.5
        decay = jnp.exp(-jnp.exp(w))
        a = jax.nn.sigmoid(a0[:, None, None, :] + jnp.einsum('dbnr,drc->dbnc', dir_own(ad), a2))
        kk = l2_normalize(split_heads(k * k_k))
        k_dir = dir_shared(k) * (1 + (a - 1) * k_a)
        gate = jax.nn.sigmoid(gd) @ g2
        xs = (split_heads(dir_shared(r)), split_heads(decay), split_heads(k_dir),
              split_heads(dir_shared(v)), dir_shared(kk), split_heads(a))
        return xs, gate

    def finish(o, xs, gate):
        r2, _, k2, v2, _, _ = xs
        bonus = jnp.sum(r2 * k2 * r_k, -1, keepdims=True) * v2
        y = group_norm(dir_sum(o), ln_g, ln_b) + dir_sum(bonus).reshape(gate.shape)
        return y * gate

    xs_ctx, g_ctx = prep(cols_ctx)
    s0 = jnp.zeros((2, cols_ctx.shape[0], GROUP_HEADS, HEAD_DIM, HEAD_DIM), jnp.float32)
    o_ctx, s_ctx = rwkv7_scan(*xs_ctx, s0)
    xs_lat, g_lat = prep(cols_lat)
    o_lat, _ = rwkv7_scan(*xs_lat, s_ctx)
    return finish(o_ctx, xs_ctx, g_ctx), finish(o_lat, xs_lat, g_lat)


def gated_deltanet_mixer(cols_ctx, cols_lat, conv_w, a_log, dt_bias, norm_g):
    def prep(cols):
        qkv, beta, alpha, g = split_cols(cols.astype(jnp.float32), C_COLS)
        q, k, v = jnp.split(jax.nn.silu(depthwise_conv(qkv, conv_w)), 3, axis=-1)
        q = head_l2(q) * HEAD_DIM ** -0.5
        k = head_l2(k)
        beta = jax.nn.sigmoid(dir_own(beta))
        log_a = -jnp.exp(a_log)[:, None, None, :] * jax.nn.softplus(dir_own(alpha) + dt_bias[:, None, None, :])
        xs = (heads(dir_shared(q)), heads(dir_shared(k)), heads(dir_shared(v)),
              head_scalars(beta), head_scalars(log_a))
        return xs, g

    def finish(o, g):
        return head_rms_norm(dir_sum(unheads(o)), norm_g) * jax.nn.silu(g)

    xs_ctx, g_ctx = prep(cols_ctx)
    s0 = jnp.zeros((2, cols_ctx.shape[0], GROUP_HEADS, HEAD_DIM, HEAD_DIM), jnp.float32)
    o_ctx, s_ctx = chunk_gated_delta(*xs_ctx, s0)
    xs_lat, g_lat = prep(cols_lat)
    o_lat, _ = chunk_gated_delta(*xs_lat, s_ctx)
    return finish(o_ctx, g_ctx), finish(o_lat, g_lat)


def mlstm_mixer(cols_ctx, cols_lat, i_bias, f_bias, norm_g):
    def prep(cols):
        qkv, ig, fg, og = split_cols(cols.astype(jnp.float32), D_COLS)
        q, k, v = jnp.split(qkv, 3, axis=-1)
        k = k * HEAD_DIM ** -0.5
        log_i = dir_own(ig) + i_bias[:, None, None, :]
        log_f = jax.nn.log_sigmoid(dir_own(fg) + f_bias[:, None, None, :])
        xs = (heads(dir_shared(q)), heads(dir_shared(k)), heads(dir_shared(v)),
              head_scalars(log_i), head_scalars(log_f))
        return xs, og

    def finish(h, og):
        return head_rms_norm(dir_sum(unheads(h)), norm_g) * jax.nn.sigmoid(og)

    xs_ctx, o_gate_ctx = prep(cols_ctx)
    bsz = cols_ctx.shape[0]
    state0 = (jnp.zeros((2, bsz, GROUP_HEADS, HEAD_DIM, HEAD_DIM), jnp.float32),
              jnp.zeros((2, bsz, GROUP_HEADS, HEAD_DIM), jnp.float32),
              jnp.zeros((2, bsz, GROUP_HEADS), jnp.float32))
    h_ctx, state_ctx = chunk_mlstm(*xs_ctx, state0)
    xs_lat, o_gate_lat = prep(cols_lat)
    h_lat, _ = chunk_mlstm(*xs_lat, state_ctx)
    return finish(h_ctx, o_gate_ctx), finish(h_lat, o_gate_lat)


def setup_inputs(seed: int = 0) -> dict:
    key = jax.random.key(seed)
    keys = iter(jax.random.split(key, 40))

    def nrm(shape, scale):
        return scale * jax.random.normal(next(keys), shape, jnp.float32)

    def uni(shape, lo, hi):
        return jax.random.uniform(next(keys), shape, jnp.float32, lo, hi)

    D, G, H, L = D_MODEL, GROUP_W, GROUP_HEADS, DEPTH
    dt = jnp.exp(uni((L, 2, H), math.log(1e-3), math.log(1e-1)))
    return {
        "x": nrm((BATCH, SEQ, D), 1.0),
        "c": nrm((BATCH, D), 1.0),
        "ctx": nrm((BATCH, CTX_LEN, D), 1.0),
        "c_ctx": nrm((D,), 1.0),
        "ada_w": nrm((L, D, 6 * D), 0.5 * D ** -0.5),
        "ada_b": nrm((L, 6 * D), 0.02),
        "w_in": nrm((L, D, D_IN), D ** -0.5),
        "w_out": nrm((L, D_MIX, D), DEEPNORM_BETA * D_MIX ** -0.5),
        "ln1_g": 1.0 + nrm((L, D), 0.05),
        "ln1_b": nrm((L, D), 0.02),
        "ln2_g": 1.0 + nrm((L, D), 0.05),
        "ln2_b": nrm((L, D), 0.02),
        "mlp_w1": nrm((L, D, D_FF), D ** -0.5),
        "mlp_w2": nrm((L, D_FF, D), DEEPNORM_BETA * D_FF ** -0.5),
        "hgrn_gamma": nrm((L, 2, G), 1.0),
        "hgrn_norm_g": 1.0 + nrm((L, G), 0.05),
        "rwkv_mu": uni((L, GROUP_COLS[1]), 0.0, 1.0),
        "rwkv_w0": nrm((L, 2, G), 0.5),
        "rwkv_w2": nrm((L, 2, RWKV_DECAY_RANK, G), 0.5 * RWKV_DECAY_RANK ** -0.5),
        "rwkv_a0": nrm((L, 2, G), 0.5),
        "rwkv_a2": nrm((L, 2, RWKV_AAA_RANK, G), 0.5 * RWKV_AAA_RANK ** -0.5),
        "rwkv_g2": nrm((L, RWKV_GATE_RANK, G), RWKV_GATE_RANK ** -0.5),
        "rwkv_k_k": 1.0 + nrm((L, G), 0.05),
        "rwkv_k_a": 1.0 + nrm((L, G), 0.05),
        "rwkv_r_k": nrm((L, H, HEAD_DIM), 0.1),
        "rwkv_ln_g": 1.0 + nrm((L, G), 0.05),
        "rwkv_ln_b": nrm((L, G), 0.02),
        "gdn_conv": nrm((L, GDN_CONV_W, 3 * G), GDN_CONV_W ** -0.5),
        "gdn_a_log": jnp.log(uni((L, 2, H), 1.0, 16.0)),
        "gdn_dt_bias": dt + jnp.log(-jnp.expm1(-dt)),
        "gdn_norm_g": 1.0 + nrm((L, G), 0.05),
        "mlstm_i_bias": nrm((L, 2, H), 0.1),
        "mlstm_f_bias": 3.0 + nrm((L, 2, H), 0.5),
        "mlstm_norm_g": 1.0 + nrm((L, G), 0.05),
    }


def reference(x, c, ctx, c_ctx, ada_w, ada_b, w_in, w_out, ln1_g, ln1_b, ln2_g, ln2_b,
              mlp_w1, mlp_w2, hgrn_gamma, hgrn_norm_g, rwkv_mu, rwkv_w0, rwkv_w2, rwkv_a0,
              rwkv_a2, rwkv_g2, rwkv_k_k, rwkv_k_a, rwkv_r_k, rwkv_ln_g, rwkv_ln_b, gdn_conv,
              gdn_a_log, gdn_dt_bias, gdn_norm_g, mlstm_i_bias, mlstm_f_bias, mlstm_norm_g):
    for layer in range(DEPTH):
        last = layer == DEPTH - 1
        mod_lat = jnp.split((jax.nn.silu(c) @ ada_w[layer] + ada_b[layer])[:, None, :], 6, axis=-1)
        mod_ctx = jnp.split((jax.nn.silu(c_ctx) @ ada_w[layer] + ada_b[layer])[None, None, :], 6, axis=-1)
        h_lat = modulate(x, mod_lat[0], mod_lat[1])
        h_ctx = modulate(ctx, mod_ctx[0], mod_ctx[1])
        p_ctx = split_cols(h_ctx @ w_in[layer], GROUP_COLS)
        p_lat = split_cols(h_lat @ w_in[layer], GROUP_COLS)
        odd = layer % 2 == 1
        col_major = (odd, odd, not odd, not odd)
        p_lat = [to_col_major(t) if cm else t for t, cm in zip(p_lat, col_major)]
        outs = [
            hgrn2_mixer(p_ctx[0], p_lat[0], hgrn_gamma, layer, hgrn_norm_g[layer]),
            rwkv7_mixer(p_ctx[1], p_lat[1], rwkv_mu[layer], rwkv_w0[layer], rwkv_w2[layer],
                        rwkv_a0[layer], rwkv_a2[layer], rwkv_g2[layer], rwkv_k_k[layer],
                        rwkv_k_a[layer], rwkv_r_k[layer], rwkv_ln_g[layer], rwkv_ln_b[layer]),
            gated_deltanet_mixer(p_ctx[2], p_lat[2], gdn_conv[layer], gdn_a_log[layer],
                                 gdn_dt_bias[layer], gdn_norm_g[layer]),
            mlstm_mixer(p_ctx[3], p_lat[3], mlstm_i_bias[layer], mlstm_f_bias[layer],
                        mlstm_norm_g[layer]),
        ]
        y_lat = jnp.concatenate([from_col_major(o[1]) if cm else o[1] for o, cm in zip(outs, col_major)], axis=-1)
        y_lat = y_lat.astype(x.dtype) @ w_out[layer]
        x = layer_norm(DEEPNORM_ALPHA * x + mod_lat[2] * y_lat, ln1_g[layer], ln1_b[layer])
        y_mlp = squared_relu_mlp(modulate(x, mod_lat[3], mod_lat[4]), mlp_w1[layer], mlp_w2[layer])
        x = layer_norm(DEEPNORM_ALPHA * x + mod_lat[5] * y_mlp, ln2_g[layer], ln2_b[layer])
        if not last:
            y_ctx = jnp.concatenate([o[0] for o in outs], axis=-1).astype(ctx.dtype) @ w_out[layer]
            ctx = layer_norm(DEEPNORM_ALPHA * ctx + mod_ctx[2] * y_ctx, ln1_g[layer], ln1_b[layer])
            y_mlp_ctx = squared_relu_mlp(modulate(ctx, mod_ctx[3], mod_ctx[4]), mlp_w1[layer], mlp_w2[layer])
            ctx = layer_norm(DEEPNORM_ALPHA * ctx + mod_ctx[5] * y_mlp_ctx, ln2_g[layer], ln2_b[layer])
    return x
```

```cpp
#include <hip/hip_runtime.h>
#include <hip/hip_cooperative_groups.h>
#include <cstdio>
namespace cg = cooperative_groups;

#define LAS __attribute__((address_space(3)))
typedef unsigned short bf16_t;
typedef short bf16x8 __attribute__((ext_vector_type(8)));
typedef float f32x4 __attribute__((ext_vector_type(4)));
typedef unsigned u32x4 __attribute__((ext_vector_type(4)));
typedef unsigned u32x2 __attribute__((ext_vector_type(2)));

constexpr int NTOK = 17408, NLAT = 16384, DM = 1024, LDP = 4608, DIN = 4512, DFF = 4096, NLAYER = 4;
constexpr int NCHUNK = 272;
constexpr float ALPHA = 1.681792830507429f;
enum { I_X = 0, I_C, I_CTX, I_CCTX, I_ADAW, I_ADAB, I_WIN, I_WOUT, I_LN1G, I_LN1B, I_LN2G, I_LN2B, I_W1, I_W2, I_HGAMMA, I_HNORM,
       I_RMU, I_RW0, I_RW2, I_RA0, I_RA2, I_RG2, I_RKK, I_RKA, I_RRK, I_RLNG, I_RLNB, I_GCONV, I_GALOG, I_GDT, I_GNORM, I_MIB, I_MFB, I_MNORM };
constexpr size_t al256(size_t x) { return (x + 255) & ~(size_t)255; }
constexpr size_t OFF_XC = 0;
constexpr size_t OFF_MOD = OFF_XC + (size_t)1024 * 1024 * 4;
constexpr size_t OFF_LB = OFF_MOD + al256((size_t)NLAYER * 5 * 6144 * 4);
constexpr size_t OFF_GS = OFF_LB + al256((size_t)NLAYER * 2 * 256 * 4);
constexpr size_t OFF_WIN = OFF_GS + al256((size_t)NTOK * 16 * 4);
constexpr size_t OFF_WOUT = OFF_WIN + (size_t)LDP * 1024 * 2;
constexpr size_t OFF_W1 = OFF_WOUT + (size_t)1024 * 1024 * 2;
constexpr size_t OFF_W2 = OFF_W1 + (size_t)4096 * 1024 * 2;
constexpr size_t OFF_WC = OFF_W2 + (size_t)4096 * 1024 * 2;
constexpr size_t OFF_P = OFF_WC + al256((size_t)1280 * 384 * 2);
constexpr size_t OFF_O = OFF_P + (size_t)NTOK * LDP * 2;
constexpr size_t OFF_RP = OFF_O + (size_t)2 * NTOK * 1024 * 2;
constexpr size_t OFF_GP = OFF_RP + (size_t)NTOK * 2304 * 2;
constexpr size_t WS_END = OFF_GP + (size_t)NTOK * 768 * 2;
constexpr size_t OFF_YMIX = OFF_O, OFF_U = OFF_O, OFF_MODP = OFF_O, OFF_HA = OFF_O + (size_t)NTOK * 1024 * 2, OFF_HID = OFF_P;

struct KP { const float* in[34]; float* out; unsigned char* ws; };

__device__ __forceinline__ float bf2f(unsigned short b) { return __uint_as_float(((unsigned)b) << 16); }
__device__ __forceinline__ float bflo(unsigned u) { return __uint_as_float(u << 16); }
__device__ __forceinline__ float bfhi(unsigned u) { return __uint_as_float(u & 0xffff0000u); }
__device__ __forceinline__ unsigned cvt_pk_bf16(float lo, float hi) { unsigned r; asm volatile("v_cvt_pk_bf16_f32 %0, %1, %2" : "=v"(r) : "v"(lo), "v"(hi)); return r; }
__device__ __forceinline__ unsigned short f2bf(float f) { return (unsigned short)(cvt_pk_bf16(f, 0.f) & 0xffffu); }
template <int CTRL> __device__ __forceinline__ float dppf(float x) { return __builtin_bit_cast(float, __builtin_amdgcn_mov_dpp(__builtin_bit_cast(int, x), CTRL, 0xf, 0xf, true)); }
__device__ __forceinline__ float allred16(float x) { x += dppf<0x128>(x); x += dppf<0x124>(x); x += dppf<0x4E>(x); x += dppf<0xB1>(x); return x; }
__device__ __forceinline__ float allred64(float x) { x = allred16(x); x += __shfl_xor(x, 16); x += __shfl_xor(x, 32); return x; }
__device__ __forceinline__ float sigmoidf_(float x) { return 1.0f / (1.0f + __expf(-x)); }
__device__ __forceinline__ float siluf_(float x) { return x / (1.0f + __expf(-x)); }
__device__ __forceinline__ float softplusf_(float x) { return fmaxf(x, 0.f) + __logf(1.0f + __expf(-fabsf(x))); }
__device__ __forceinline__ int otid() { int t = threadIdx.x; asm volatile("" : "+v"(t)); return t; }
__device__ __forceinline__ float* xrow(const KP& p, int row) { return row < NLAT ? p.out + (size_t)row * DM : (float*)(p.ws + OFF_XC) + (size_t)(row - NLAT) * DM; }
__device__ __forceinline__ int cmperm(int n) { return ((n & 63) << 6) | (n >> 6); }
__device__ __forceinline__ int seq_row(int s, int d, int b, int cm) {
  if (s < 256) { const int p = d ? 255 - s : s; return NLAT + b * 256 + p; }
  const int q = s - 256, p = d ? 4095 - q : q; return b * 4096 + (cm ? cmperm(p) : p);
}
__device__ __forceinline__ int nbr_row(int r, int cm, int dp) {
  if (r >= NLAT) { const int q = r - NLAT, b = q >> 8, p = (q & 255) + dp; return (p < 0 || p > 255) ? -1 : NLAT + b * 256 + p; }
  const int b = r >> 12, n = r & 4095; int p = (cm ? cmperm(n) : n) + dp; if (p < 0 || p > 4095) return -1;
  return b * 4096 + (cm ? cmperm(p) : p);
}
__device__ __forceinline__ void unpack4(u32x2 u, float (&f)[4]) { f[0] = bflo(u.x); f[1] = bfhi(u.x); f[2] = bflo(u.y); f[3] = bfhi(u.y); }
__device__ __forceinline__ u32x2 pack4(const float (&f)[4]) { u32x2 u; u.x = cvt_pk_bf16(f[0], f[1]); u.y = cvt_pk_bf16(f[2], f[3]); return u; }

namespace pg8 {
constexpr int BM = 256, BK = 64, HALF = 128, HTB = HALF * BK * 2, STAGE_BYTES = 8 * HTB, NXCD = 8, WGM = 8;
__host__ __device__ __forceinline__ int lds_byte(int r, int c) { const int st = (r >> 4) * 2 + (c >> 5), rr = r & 15, cc = c & 31, ob = rr * 64 + cc * 2; return st * 1024 + (ob ^ (((ob >> 9) & 1) << 5)); }
__host__ __device__ __forceinline__ void stage_rc(int b, int& R, int& C) { const int st = b / 1024, sb = b % 1024, swz = sb ^ (((sb >> 9) & 1) << 5); R = (st >> 1) * 16 + swz / 64; C = (st & 1) * 32 + (swz % 64) / 2; }
__host__ __device__ __forceinline__ int perm32(int rho) { const int n = rho >> 4, i = rho & 15; return 8 * (i >> 2) + 4 * n + (i & 3); }
struct Unit { int pm, pn; };
struct Gemm { const bf16_t* A; const bf16_t* Bt; int M, N, K; };
struct StaticOrder {
  int nM, nN, nwg, G, c;
  __device__ void init(int M, int N, int G_, int c_) { nM = M / BM; nN = N / BM; nwg = nM * nN; G = G_; c = c_; }
  __device__ bool next(int i, Unit& u) const {
    const long L = (long)i * G + c; if (L >= nwg) return false;
    int wgid = (int)L; { const int q = nwg / NXCD, r = nwg % NXCD, xcd = wgid % NXCD, off = wgid / NXCD; wgid = (xcd < r ? xcd * (q + 1) : r * (q + 1) + (xcd - r) * q) + off; }
    const int nig = WGM * nN, gid = wgid / nig, fm = gid * WGM, gsz = (nM - fm) < WGM ? (nM - fm) : WGM;
    u.pm = fm + ((wgid % nig) % gsz); u.pn = (wgid % nig) / gsz; return true;
  }
};

template <class Epi>
__device__ __forceinline__ void gemm_phase(LAS unsigned char* lds, const Gemm g, const StaticOrder& S, const Epi& E) {
  const int tid = otid(), wid = __builtin_amdgcn_readfirstlane(tid >> 6), lane = tid & 63, wr = wid >> 2, wc = wid & 3, fr = lane & 15, fq = lane >> 4;
  int K = g.K; asm volatile("" : "+s"(K));
  const int nt = K / BK;
  unsigned voffA[2], voffB[2];
#pragma unroll
  for (int i = 0; i < 2; ++i) { int R, C; stage_rc(tid * 16 + i * 8192, R, C); const int Rb = Epi::PERM ? ((R & ~31) + perm32(R & 31)) : R;
    voffA[i] = (unsigned)(R * K + C) * 2u; voffB[i] = (unsigned)(Rb * K + C) * 2u; }
  const size_t kstep = (size_t)(BK * 2);
  const size_t hstep = (size_t)HALF * K * 2;
  const size_t tstep = 2 * hstep;
  const unsigned ldsw = (unsigned)wid * 1024u;
  const int aoff = lds_byte(wr * 64 + fr, fq * 8), boff = lds_byte(wc * 32 + fr, fq * 8);
#define PG8_SA(b, h) (((b) * 2 + (h)) * HTB)
#define PG8_SB(b, h) ((4 + (b) * 2 + (h)) * HTB)
#define PG8_STAGE(bufoff, gbase, voff) do { _Pragma("unroll") for (int _i = 0; _i < 2; ++_i) \
    __builtin_amdgcn_global_load_lds((const unsigned*)((const char*)(gbase) + (voff)[_i]), (LAS unsigned*)(lds + (bufoff) + ldsw + _i * 8192), 16, 0, 0); } while (0)
#define PG8_LDA(dst, b, h) do { _Pragma("unroll") for (int m = 0; m < 4; ++m) _Pragma("unroll") for (int k = 0; k < 2; ++k) dst[m][k] = *(const LAS bf16x8*)(lds + PG8_SA(b, h) + aoff + m * 2048 + k * 1024); } while (0)
#define PG8_LDB(dst, b, h) do { _Pragma("unroll") for (int n = 0; n < 2; ++n) _Pragma("unroll") for (int k = 0; k < 2; ++k) dst[n][k] = *(const LAS bf16x8*)(lds + PG8_SB(b, h) + boff + n * 2048 + k * 1024); } while (0)
#define PG8_MMA(ai, bj, At, Bt) do { __builtin_amdgcn_s_setprio(1); _Pragma("unroll") for (int m = 0; m < 4; ++m) _Pragma("unroll") for (int n = 0; n < 2; ++n) _Pragma("unroll") for (int k = 0; k < 2; ++k) \
    acc[ai][bj][m][n] = __builtin_amdgcn_mfma_f32_16x16x32_bf16(Bt[n][k], At[m][k], acc[ai][bj][m][n], 0, 0, 0); __builtin_amdgcn_s_setprio(0); } while (0)
#define PG8_WAIT_V(n) asm volatile("s_waitcnt vmcnt(" #n ")" ::: "memory")
#define PG8_WAIT_L(n) asm volatile("s_waitcnt lgkmcnt(" #n ")" ::: "memory")
#define PG8_BAR __builtin_amdgcn_s_barrier()
#define PG8_SCHED __builtin_amdgcn_sched_barrier(0)
  Unit cur, nxt; int ui = 0;
  if (!S.next(0, cur)) return;
  f32x4 acc[2][2][4][2];
#pragma unroll
  for (int a = 0; a < 2; ++a)
#pragma unroll
    for (int b = 0; b < 2; ++b)
#pragma unroll
      for (int m = 0; m < 4; ++m)
#pragma unroll
        for (int n = 0; n < 2; ++n) acc[a][b][m][n] = (f32x4){0.f, 0.f, 0.f, 0.f};
  bf16x8 At[4][2], B0[2][2], B1[2][2];
  const char* cA = (const char*)g.A + (size_t)cur.pm * tstep; const char* cB = (const char*)g.Bt + (size_t)cur.pn * tstep;
  PG8_STAGE(PG8_SB(0, 0), cB, voffB); PG8_STAGE(PG8_SA(0, 0), cA, voffA); PG8_STAGE(PG8_SB(0, 1), cB + hstep, voffB); PG8_STAGE(PG8_SA(0, 1), cA + hstep, voffA);
  if (wr == 1) PG8_BAR;
  PG8_WAIT_V(4); PG8_BAR;
  PG8_STAGE(PG8_SB(1, 0), cB + kstep, voffB); PG8_STAGE(PG8_SA(1, 0), cA + kstep, voffA); PG8_STAGE(PG8_SB(1, 1), cB + hstep + kstep, voffB);
  PG8_WAIT_V(6); PG8_BAR;
  for (;;) {
    const bool has_next = S.next(ui + 1, nxt);
    const char* nA = has_next ? (const char*)g.A + (size_t)nxt.pm * tstep : cA; const char* nB = has_next ? (const char*)g.Bt + (size_t)nxt.pn * tstep : cB;
    for (int t = 0; t < nt; t += 2) {
      const bool last = (t == nt - 2);
      const char* a1 = cA + (size_t)(t + 1) * kstep;
      const char* a2 = last ? nA : cA + (size_t)(t + 2) * kstep; const char* b2 = last ? nB : cB + (size_t)(t + 2) * kstep;
      const char* a3 = a2 + kstep; const char* b3 = b2 + kstep;
      PG8_LDB(B0, 0, 0); PG8_SCHED; PG8_LDA(At, 0, 0); PG8_STAGE(PG8_SA(1, 1), a1 + hstep, voffA);
      PG8_WAIT_L(8); PG8_BAR; PG8_WAIT_L(0); PG8_MMA(0, 0, At, B0); PG8_BAR; PG8_SCHED;
      PG8_LDB(B1, 0, 1); PG8_STAGE(PG8_SB(0, 0), b2, voffB);
      PG8_BAR; PG8_WAIT_L(0); PG8_MMA(0, 1, At, B1); PG8_BAR;
      PG8_LDA(At, 0, 1); PG8_STAGE(PG8_SA(0, 0), a2, voffA);
      PG8_BAR; PG8_WAIT_L(0); PG8_MMA(1, 0, At, B0); PG8_BAR; PG8_SCHED;
      PG8_STAGE(PG8_SB(0, 1), b2 + hstep, voffB);
      PG8_WAIT_V(6); PG8_BAR; PG8_MMA(1, 1, At, B1); PG8_BAR;
      PG8_LDB(B0, 1, 0); PG8_SCHED; PG8_LDA(At, 1, 0); PG8_STAGE(PG8_SA(0, 1), a2 + hstep, voffA);
      PG8_WAIT_L(8); PG8_BAR; PG8_WAIT_L(0); PG8_MMA(0, 0, At, B0); PG8_BAR; PG8_SCHED;
      PG8_LDB(B1, 1, 1); PG8_STAGE(PG8_SB(1, 0), b3, voffB);
      PG8_BAR; PG8_WAIT_L(0); PG8_MMA(0, 1, At, B1); PG8_BAR;
      PG8_LDA(At, 1, 1); PG8_STAGE(PG8_SA(1, 0), a3, voffA);
      PG8_BAR; PG8_WAIT_L(0); PG8_MMA(1, 0, At, B0); PG8_BAR; PG8_SCHED;
      PG8_STAGE(PG8_SB(1, 1), b3 + hstep, voffB);
      PG8_WAIT_V(6); PG8_BAR; PG8_MMA(1, 1, At, B1); PG8_BAR;
    }
    E(acc, cur, wr, wc, fr, fq);
    if (!has_next) break;
#pragma unroll
    for (int a = 0; a < 2; ++a)
#pragma unroll
      for (int b = 0; b < 2; ++b)
#pragma unroll
        for (int m = 0; m < 4; ++m)
#pragma unroll
          for (int n = 0; n < 2; ++n) acc[a][b][m][n] = (f32x4){0.f, 0.f, 0.f, 0.f};
    cur = nxt; cA = nA; cB = nB; ++ui;
  }
  PG8_WAIT_V(0);
  if (wr == 0) PG8_BAR;
  PG8_BAR;
#undef PG8_SA
#undef PG8_SB
#undef PG8_STAGE
#undef PG8_LDA
#undef PG8_LDB
#undef PG8_MMA
#undef PG8_WAIT_V
#undef PG8_WAIT_L
#undef PG8_BAR
#undef PG8_SCHED
}

struct EpiB {
  static constexpr bool PERM = true;
  bf16_t* O; int ldc; int mode; const float* aux0; const float* aux1;
  __device__ __forceinline__ void operator()(const f32x4 (&acc)[2][2][4][2], const Unit& u, int wr, int wc, int fr, int fq) const {
    const int row0 = u.pm * BM + wr * 64 + fr;
    const int cin = wc * 32 + 8 * fq;
    const int col0 = (mode == 2 ? 1024 : 0) + u.pn * BM + cin;
    const bool special = (mode == 0) ? (u.pn == 2 || u.pn == 3) : (mode == 2 ? (u.pn < 4) : false);
    const float* auxp = nullptr;
    if (mode == 0) auxp = aux0 + ((u.pn - 2) & 1) * 256 + cin;
    if (mode == 2) auxp = (u.pn < 2 ? aux0 : aux1) + (u.pn & 1) * 256 + cin;
#pragma unroll
    for (int ai = 0; ai < 2; ++ai)
#pragma unroll
      for (int m = 0; m < 4; ++m) {
        bf16_t* rowp = O + (size_t)(row0 + ai * HALF + m * 16) * ldc + col0;
#pragma unroll
        for (int bj = 0; bj < 2; ++bj) {
          float v[8];
#pragma unroll
          for (int j = 0; j < 4; ++j) { v[j] = acc[ai][bj][m][0][j]; v[4 + j] = acc[ai][bj][m][1][j]; }
          if (mode == 1) {
#pragma unroll
            for (int j = 0; j < 8; ++j) { const float r = fmaxf(v[j], 0.f); v[j] = r * r; }
          } else if (special) {
            const f32x4 x0 = *(const f32x4*)(auxp + bj * HALF), x1 = *(const f32x4*)(auxp + bj * HALF + 4);
            if (mode == 0) {
#pragma unroll
              for (int j = 0; j < 4; ++j) { v[j] = (1.0f - x0[j]) / (1.0f + __expf(v[j])); v[4 + j] = (1.0f - x1[j]) / (1.0f + __expf(v[4 + j])); }
            } else {
#pragma unroll
              for (int j = 0; j < 4; ++j) { v[j] += x0[j]; v[4 + j] += x1[j]; }
            }
          }
          u32x4 w; w.x = cvt_pk_bf16(v[0], v[1]); w.y = cvt_pk_bf16(v[2], v[3]); w.z = cvt_pk_bf16(v[4], v[5]); w.w = cvt_pk_bf16(v[6], v[7]);
          *(u32x4*)(rowp + bj * HALF) = w;
        }
      }
  }
};
struct EpiR {
  static constexpr bool PERM = false;
  float* xlat; float* xctx; const float* gate;
  __device__ __forceinline__ void operator()(const f32x4 (&acc)[2][2][4][2], const Unit& u, int wr, int wc, int fr, int fq) const {
    const int row0 = u.pm * BM + wr * 64 + fr, col0 = u.pn * BM + wc * 32 + 4 * fq;
    const int b5 = (u.pm < 64) ? (u.pm >> 4) : 4;
    f32x4 gv[2][2];
#pragma unroll
    for (int bj = 0; bj < 2; ++bj)
#pragma unroll
      for (int n = 0; n < 2; ++n) gv[bj][n] = *(const f32x4*)(gate + (size_t)b5 * 6144 + col0 + bj * HALF + n * 16);
#pragma unroll
    for (int ai = 0; ai < 2; ++ai)
#pragma unroll
      for (int m = 0; m < 4; ++m) {
        const int row = row0 + ai * HALF + m * 16;
        float* rowp = (row < NLAT ? xlat + (size_t)row * DM : xctx + (size_t)(row - NLAT) * DM) + col0;
#pragma unroll
        for (int bj = 0; bj < 2; ++bj)
#pragma unroll
          for (int n = 0; n < 2; ++n) { f32x4 xv = *(f32x4*)(rowp + bj * HALF + n * 16); xv = xv * ALPHA + gv[bj][n] * acc[ai][bj][m][n]; *(f32x4*)(rowp + bj * HALF + n * 16) = xv; }
      }
  }
};
}

__device__ void phase_convert_weights(const KP& p, int layer, float* tile  ) {
  const int tid = otid();
  bf16_t* dWIN = (bf16_t*)(p.ws + OFF_WIN); bf16_t* dWOUT = (bf16_t*)(p.ws + OFF_WOUT); bf16_t* dW1 = (bf16_t*)(p.ws + OFF_W1); bf16_t* dW2 = (bf16_t*)(p.ws + OFF_W2);
  for (int T = blockIdx.x; T < 3456; T += gridDim.x) {
    const float* src; bf16_t* dst; int K, N, t;
    if (T < 1152) { t = T; src = p.in[I_WIN] + (size_t)layer * 1024 * DIN; dst = dWIN; K = 1024; N = DIN; }
    else if (T < 1408) { t = T - 1152; src = p.in[I_WOUT] + (size_t)layer * 1024 * 1024; dst = dWOUT; K = 1024; N = 1024; }
    else if (T < 2432) { t = T - 1408; src = p.in[I_W1] + (size_t)layer * 1024 * DFF; dst = dW1; K = 1024; N = DFF; }
    else { t = T - 2432; src = p.in[I_W2] + (size_t)layer * DFF * 1024; dst = dW2; K = DFF; N = 1024; }
    const int nk = K / 64, tk = t % nk, tn = t / nk;
    { const int j = tid & 63, i0 = tid >> 6;
#pragma unroll
      for (int ii = 0; ii < 8; ++ii) { const int i = i0 + ii * 8; const int n = tn * 64 + j; tile[i * 65 + j] = (n < N) ? src[(size_t)(tk * 64 + i) * N + n] : 0.f; } }
    __syncthreads();
    { const int i2 = (tid & 31) * 2, j0 = tid >> 5;
#pragma unroll
      for (int jj = 0; jj < 4; ++jj) { const int j = j0 + jj * 16; *(unsigned*)(dst + (size_t)(tn * 64 + j) * K + tk * 64 + i2) = cvt_pk_bf16(tile[i2 * 65 + j], tile[(i2 + 1) * 65 + j]); } }
    __syncthreads();
  }
  bf16_t* dWC = (bf16_t*)(p.ws + OFF_WC);
  const float* w2 = p.in[I_RW2] + (size_t)layer * 2 * 64 * 256; const float* a2 = p.in[I_RA2] + (size_t)layer * 2 * 64 * 256; const float* g2 = p.in[I_RG2] + (size_t)layer * 128 * 256;
  for (int idx = blockIdx.x * 512 + tid; idx < 1280 * 384; idx += gridDim.x * 512) {
    const int n = idx / 384, kk = idx % 384, seg = n >> 8, c = n & 255; float v = 0.f;
    if (seg < 2) { if ((kk >> 6) == seg) v = w2[((size_t)seg * 64 + (kk & 63)) * 256 + c]; }
    else if (seg < 4) { if ((kk >> 6) == seg) v = a2[((size_t)(seg - 2) * 64 + (kk & 63)) * 256 + c]; }
    else { if (kk >= 256) v = g2[(size_t)(kk - 256) * 256 + c]; }
    dWC[idx] = f2bf(v);
  }
}

__device__ void phase_modulate(const KP& p, int layer) {
  const int tid_ = otid(), lane = tid_ & 63, wave = tid_ >> 6;
  const float* mod = (const float*)(p.ws + OFF_MOD) + (size_t)layer * 5 * 6144;
  bf16_t* HA = (bf16_t*)(p.ws + OFF_HA);
  for (int row = blockIdx.x * 8 + wave; row < NTOK; row += gridDim.x * 8) {
    const float* xr = xrow(p, row); const int b5 = row < NLAT ? row >> 12 : 4; const float* mb = mod + (size_t)b5 * 6144;
#pragma unroll
    for (int q = 0; q < 4; ++q) { const int c = q * 256 + lane * 4; const f32x4 xv = *(const f32x4*)(xr + c), sh = *(const f32x4*)(mb + c), sc = *(const f32x4*)(mb + 1024 + c);
      float y[4];
#pragma unroll
      for (int j = 0; j < 4; ++j) y[j] = xv[j] * (1.0f + sc[j]) + sh[j];
      *(u32x2*)(HA + (size_t)row * DM + c) = pack4(y); }
  }
}

__device__ void phase_ln(const KP& p, const float* g, const float* bta, const float* mod_next, int sh_off, int nrows) {
  const int tid_ = otid(), lane = tid_ & 63, wave = tid_ >> 6;
  bf16_t* HA = (bf16_t*)(p.ws + OFF_HA);
  for (int row = blockIdx.x * 8 + wave; row < nrows; row += gridDim.x * 8) {
    float* xr = xrow(p, row); const int b5 = row < NLAT ? row >> 12 : 4;
    f32x4 v[4]; float s = 0.f;
#pragma unroll
    for (int q = 0; q < 4; ++q) { v[q] = *(const f32x4*)(xr + q * 256 + lane * 4); s += v[q][0] + v[q][1] + v[q][2] + v[q][3]; }
    const float mu = allred64(s) * (1.0f / 1024.0f);
    float s2 = 0.f;
#pragma unroll
    for (int q = 0; q < 4; ++q)
#pragma unroll
      for (int j = 0; j < 4; ++j) { v[q][j] -= mu; s2 += v[q][j] * v[q][j]; }
    const float rstd = rsqrtf(allred64(s2) * (1.0f / 1024.0f) + 1e-5f);
#pragma unroll
    for (int q = 0; q < 4; ++q) { const int c = q * 256 + lane * 4; const f32x4 gg = *(const f32x4*)(g + c), bb = *(const f32x4*)(bta + c);
      f32x4 y;
#pragma unroll
      for (int j = 0; j < 4; ++j) y[j] = v[q][j] * rstd * gg[j] + bb[j];
      *(f32x4*)(xr + c) = y;
      if (mod_next) { const float* mb = mod_next + (size_t)b5 * 6144 + sh_off; const f32x4 sh = *(const f32x4*)(mb + c), sc = *(const f32x4*)(mb + 1024 + c);
        float h[4];
#pragma unroll
        for (int j = 0; j < 4; ++j) h[j] = y[j] * (1.0f + sc[j]) + sh[j];
        *(u32x2*)(HA + (size_t)row * DM + c) = pack4(h); } }
  }
}

__device__ void phase_prep(const KP& p, int layer) {
  const int tid_ = otid(), lane = tid_ & 63, wave = tid_ >> 6;
  const int odd = layer & 1, cmB = odd, cmC = !odd;
  const bf16_t* P = (const bf16_t*)(p.ws + OFF_P); bf16_t* RP = (bf16_t*)(p.ws + OFF_RP); bf16_t* GP = (bf16_t*)(p.ws + OFF_GP); bf16_t* U = (bf16_t*)(p.ws + OFF_U);
  float* GS = (float*)(p.ws + OFF_GS);
  const float* mu = p.in[I_RMU] + (size_t)layer * 1152; const float* k_k = p.in[I_RKK] + (size_t)layer * 256;
  const float* conv = p.in[I_GCONV] + (size_t)layer * 5 * 768;
  for (int row = blockIdx.x * 8 + wave; row < NTOK; row += gridDim.x * 8) {
    { const int rm = nbr_row(row, cmB, -1), rp = nbr_row(row, cmB, +1);
      const bf16_t* b0 = P + (size_t)row * LDP + 1280; const bf16_t* bm = rm >= 0 ? P + (size_t)rm * LDP + 1280 : nullptr; const bf16_t* bp = rp >= 0 ? P + (size_t)rp * LDP + 1280 : nullptr;
#pragma unroll
      for (int seg = 0; seg < 3; ++seg) { const int c = seg * 256 + lane * 4; float x0[4], xm[4] = {0.f, 0.f, 0.f, 0.f}, xp[4] = {0.f, 0.f, 0.f, 0.f}, y[4];
        unpack4(*(const u32x2*)(b0 + c), x0); if (bm) unpack4(*(const u32x2*)(bm + c), xm); if (bp) unpack4(*(const u32x2*)(bp + c), xp);
        const f32x4 m4 = *(const f32x4*)(mu + c);
#pragma unroll
        for (int j = 0; j < 4; ++j) y[j] = x0[j] + m4[j] * (0.5f * (xm[j] + xp[j]) - x0[j]);
        *(u32x2*)(RP + (size_t)row * 2304 + c) = pack4(y);
        if (seg == 1) { const f32x4 kk4 = *(const f32x4*)(k_k + lane * 4); float t[4], ss = 0.f;
#pragma unroll
          for (int j = 0; j < 4; ++j) { t[j] = y[j] * kk4[j]; ss += t[j] * t[j]; }
          const float rn = rsqrtf(allred16(ss) + 1e-12f);
#pragma unroll
          for (int j = 0; j < 4; ++j) t[j] *= rn;
          *(u32x2*)(RP + (size_t)row * 2304 + 768 + lane * 4) = pack4(t); } }
#pragma unroll
      for (int seg = 0; seg < 3; ++seg) { const int c = 768 + seg * 128 + lane * 2;
        const unsigned u0 = *(const unsigned*)(b0 + c), um = bm ? *(const unsigned*)(bm + c) : 0u, up = bp ? *(const unsigned*)(bp + c) : 0u;
        float y0 = bflo(u0), y1 = bfhi(u0);
        y0 = y0 + mu[c] * (0.5f * (bflo(um) + bflo(up)) - y0); y1 = y1 + mu[c + 1] * (0.5f * (bfhi(um) + bfhi(up)) - y1);
        if (seg == 0) { y0 = tanhf(y0); y1 = tanhf(y1); } else if (seg == 2) { y0 = sigmoidf_(y0); y1 = sigmoidf_(y1); }
        *(unsigned*)(U + (size_t)row * 384 + seg * 128 + lane * 2) = cvt_pk_bf16(y0, y1); } }
    { const bf16_t* br[5];
#pragma unroll
      for (int j = 0; j < 5; ++j) { const int rj = (j == 2) ? row : nbr_row(row, cmC, j - 2); br[j] = rj >= 0 ? P + (size_t)rj * LDP + 2432 : nullptr; }
#pragma unroll
      for (int seg = 0; seg < 3; ++seg) { const int c = seg * 256 + lane * 4; float a[4] = {0.f, 0.f, 0.f, 0.f};
#pragma unroll
        for (int j = 0; j < 5; ++j) if (br[j]) { float xv[4]; unpack4(*(const u32x2*)(br[j] + c), xv); const f32x4 w4 = *(const f32x4*)(conv + j * 768 + c);
#pragma unroll
          for (int e = 0; e < 4; ++e) a[e] += xv[e] * w4[e]; }
        float ss = 0.f;
#pragma unroll
        for (int e = 0; e < 4; ++e) { a[e] = siluf_(a[e]); ss += a[e] * a[e]; }
        if (seg < 2) { const float rn = rsqrtf(allred16(ss) + 1e-12f) * (seg == 0 ? 0.125f : 1.0f);
#pragma unroll
          for (int e = 0; e < 4; ++e) a[e] *= rn; }
        *(u32x2*)(GP + (size_t)row * 768 + c) = pack4(a); }
      if (lane < 16) { const int dh = lane & 7; float val;
        if (lane < 8) val = sigmoidf_(bf2f(P[(size_t)row * LDP + 3200 + dh]));
        else { const float la = -__expf(p.in[I_GALOG][layer * 8 + dh]) * softplusf_(bf2f(P[(size_t)row * LDP + 3208 + dh]) + p.in[I_GDT][layer * 8 + dh]); val = __expf(la); }
        GS[(size_t)row * 16 + lane] = val; } }
  }
}

__device__ void phase_finish(const KP& p, int layer, int nrows) {
  const int tid_ = otid(), lane = tid_ & 63, wave = tid_ >> 6;
  const bf16_t* P = (const bf16_t*)(p.ws + OFF_P); const bf16_t* RP = (const bf16_t*)(p.ws + OFF_RP);
  bf16_t* O0 = (bf16_t*)(p.ws + OFF_O); const bf16_t* O1 = O0 + (size_t)NTOK * 1024;
  const float* hn = p.in[I_HNORM] + layer * 256; const float* gn = p.in[I_GNORM] + layer * 256; const float* mn = p.in[I_MNORM] + layer * 256;
  const float* lng = p.in[I_RLNG] + layer * 256; const float* lnb = p.in[I_RLNB] + layer * 256; const float* k_a = p.in[I_RKA] + layer * 256; const float* r_k = p.in[I_RRK] + layer * 256;
  const int c = lane * 4;
  for (int row = blockIdx.x * 8 + wave; row < nrows; row += gridDim.x * 8) {
    float o[4][4];
#pragma unroll
    for (int g = 0; g < 4; ++g) { float a[4], b[4]; unpack4(*(const u32x2*)(O0 + (size_t)row * 1024 + g * 256 + c), a); unpack4(*(const u32x2*)(O1 + (size_t)row * 1024 + g * 256 + c), b);
#pragma unroll
      for (int j = 0; j < 4; ++j) o[g][j] = a[j] + b[j]; }
    const bf16_t* pr = P + (size_t)row * LDP; const bf16_t* rr = RP + (size_t)row * 2304;
#pragma unroll
    for (int g = 0; g < 4; ++g) { if (g == 1) continue;
      float ss = 0.f;
#pragma unroll
      for (int j = 0; j < 4; ++j) ss += o[g][j] * o[g][j];
      const float rn = rsqrtf(allred16(ss) * (1.0f / 64.0f) + 1e-6f);
      const float* ng = g == 0 ? hn : (g == 2 ? gn : mn); const int gcol = g == 0 ? 1024 : (g == 2 ? 3216 : 4256);
      float gt[4]; unpack4(*(const u32x2*)(pr + gcol + c), gt); const f32x4 n4 = *(const f32x4*)(ng + c);
      float y[4];
#pragma unroll
      for (int j = 0; j < 4; ++j) y[j] = o[g][j] * rn * n4[j] * (g == 3 ? sigmoidf_(gt[j]) : siluf_(gt[j]));
      *(u32x2*)(O0 + (size_t)row * 1024 + g * 256 + c) = pack4(y); }
    { float s = o[1][0] + o[1][1] + o[1][2] + o[1][3];
      const float mu = allred16(s) * (1.0f / 64.0f); float s2 = 0.f;
#pragma unroll
      for (int j = 0; j < 4; ++j) { o[1][j] -= mu; s2 += o[1][j] * o[1][j]; }
      const float rstd = rsqrtf(allred16(s2) * (1.0f / 64.0f) + 64e-5f);
      float r4[4], k4[4], v4[4], af[4], ab[4], gt[4];
      unpack4(*(const u32x2*)(rr + c), r4); unpack4(*(const u32x2*)(rr + 256 + c), k4); unpack4(*(const u32x2*)(rr + 512 + c), v4);
      unpack4(*(const u32x2*)(rr + 1536 + c), af); unpack4(*(const u32x2*)(rr + 1792 + c), ab); unpack4(*(const u32x2*)(rr + 2048 + c), gt);
      const f32x4 ka4 = *(const f32x4*)(k_a + c), rk4 = *(const f32x4*)(r_k + c), g4 = *(const f32x4*)(lng + c), b4 = *(const f32x4*)(lnb + c);
      float bs = 0.f;
#pragma unroll
      for (int j = 0; j < 4; ++j) { const float a0 = sigmoidf_(af[j]), a1 = sigmoidf_(ab[j]); bs += r4[j] * k4[j] * rk4[j] * ((1.0f + (a0 - 1.0f) * ka4[j]) + (1.0f + (a1 - 1.0f) * ka4[j])); }
      bs = allred16(bs);
      float y[4];
#pragma unroll
      for (int j = 0; j < 4; ++j) y[j] = (o[1][j] * rstd * g4[j] + b4[j] + bs * v4[j]) * gt[j];
      *(u32x2*)(O0 + (size_t)row * 1024 + 256 + c) = pack4(y); }
  }
}

struct ScanRegs { u32x2 r[5]; unsigned short rv; unsigned short s0, s1; };

__device__ __forceinline__ void scan_load(ScanRegs& R, int mixer, int chunk, int d, int b, int h, int rq, int cm, int lt, const KP& p) {
  if (chunk > NCHUNK - 1) chunk = NCHUNK - 1;
  const int st = lt >> 4, cq = lt & 15;
  const int row = seq_row(chunk * 16 + st, d, b, cm);
  const bf16_t* P = (const bf16_t*)(p.ws + OFF_P);
  if (mixer == 0) { const bf16_t* base = P + (size_t)row * LDP;
    R.r[0] = *(const u32x2*)(base + 512 + d * 256 + h * 64 + cq * 4); R.r[1] = *(const u32x2*)(base + h * 64 + cq * 4); R.rv = base[256 + h * 64 + rq * 16 + cq]; }
  else if (mixer == 1) { const bf16_t* base = (const bf16_t*)(p.ws + OFF_RP) + (size_t)row * 2304 + h * 64 + cq * 4;
    R.r[0] = *(const u32x2*)(base + 1024 + d * 256); R.r[1] = *(const u32x2*)(base + 1536 + d * 256); R.r[2] = *(const u32x2*)(base + 256); R.r[3] = *(const u32x2*)(base + 768); R.r[4] = *(const u32x2*)(base);
    R.rv = ((const bf16_t*)(p.ws + OFF_RP))[(size_t)row * 2304 + 512 + h * 64 + rq * 16 + cq]; }
  else if (mixer == 2) { const bf16_t* base = (const bf16_t*)(p.ws + OFF_GP) + (size_t)row * 768;
    R.r[0] = *(const u32x2*)(base + 256 + h * 64 + cq * 4); R.r[1] = *(const u32x2*)(base + h * 64 + cq * 4); R.rv = base[512 + h * 64 + rq * 16 + cq];
    if (cq == 0) { const float* gs = (const float*)(p.ws + OFF_GS) + (size_t)row * 16; R.r[2].x = __float_as_uint(gs[8 + d * 4 + h]); R.r[2].y = __float_as_uint(gs[d * 4 + h]); } }
  else { const bf16_t* base = P + (size_t)row * LDP + 3472;
    R.r[0] = *(const u32x2*)(base + 256 + h * 64 + cq * 4); R.r[1] = *(const u32x2*)(base + h * 64 + cq * 4); R.rv = base[512 + h * 64 + rq * 16 + cq];
    if (cq == 0) { R.s0 = base[768 + d * 4 + h]; R.s1 = base[776 + d * 4 + h]; } }
}
__device__ __forceinline__ void scan_stage(const ScanRegs& R, LAS float* buf, int mixer, int lt, const float (&ka)[4], float ib, float fb) {
  const int st = lt >> 4, cq = lt & 15; LAS float* v0 = buf + st * 64 + cq * 4;
  float a[4], b[4];
  if (mixer == 0) { unpack4(R.r[0], a); unpack4(R.r[1], b);
    *(LAS f32x4*)(v0) = (f32x4){1.0f - a[0], 1.0f - a[1], 1.0f - a[2], 1.0f - a[3]}; *(LAS f32x4*)(v0 + 1024) = (f32x4){a[0], a[1], a[2], a[3]}; *(LAS f32x4*)(v0 + 2048) = (f32x4){b[0], b[1], b[2], b[3]}; }
  else if (mixer == 1) { float wl[4], aa[4], k[4], kk[4], r[4]; unpack4(R.r[0], wl); unpack4(R.r[1], aa); unpack4(R.r[2], k); unpack4(R.r[3], kk); unpack4(R.r[4], r);
    #pragma unroll
    for (int j = 0; j < 4; ++j) { wl[j] = __expf(-__expf(-softplusf_(-wl[j]) - 0.5f)); aa[j] = sigmoidf_(aa[j]); }
    *(LAS f32x4*)(v0) = (f32x4){wl[0], wl[1], wl[2], wl[3]};
    *(LAS f32x4*)(v0 + 1024) = (f32x4){kk[0] * aa[0], kk[1] * aa[1], kk[2] * aa[2], kk[3] * aa[3]};
    *(LAS f32x4*)(v0 + 2048) = (f32x4){k[0] * (1.0f + (aa[0] - 1.0f) * ka[0]), k[1] * (1.0f + (aa[1] - 1.0f) * ka[1]), k[2] * (1.0f + (aa[2] - 1.0f) * ka[2]), k[3] * (1.0f + (aa[3] - 1.0f) * ka[3])};
    *(LAS f32x4*)(v0 + 3072) = (f32x4){kk[0], kk[1], kk[2], kk[3]}; *(LAS f32x4*)(v0 + 4096) = (f32x4){r[0], r[1], r[2], r[3]}; }
  else if (mixer == 2) { unpack4(R.r[0], a); unpack4(R.r[1], b);
    *(LAS f32x4*)(v0) = (f32x4){a[0], a[1], a[2], a[3]}; *(LAS f32x4*)(v0 + 1024) = (f32x4){b[0], b[1], b[2], b[3]};
    if (cq == 0) { buf[5376 + st] = __uint_as_float(R.r[2].x); buf[5392 + st] = __uint_as_float(R.r[2].y); } }
  else { unpack4(R.r[0], a); unpack4(R.r[1], b);
    *(LAS f32x4*)(v0) = (f32x4){a[0] * 0.125f, a[1] * 0.125f, a[2] * 0.125f, a[3] * 0.125f}; *(LAS f32x4*)(v0 + 1024) = (f32x4){b[0], b[1], b[2], b[3]};
    if (cq == 0) { buf[5376 + st] = sigmoidf_(bf2f(R.s1) + fb); buf[5392 + st] = __expf(bf2f(R.s0) + ib); } }
  buf[5120 + lt] = bf2f(R.rv);
}
template <int NV> struct StepV { f32x4 v[NV]; float rv, s0, s1; };
template <int NV, bool SC> __device__ __forceinline__ void ld_step(StepV<NV>& S, const LAS float* vb, const LAS float* buf, int t, int rw) {
#pragma unroll
  for (int i = 0; i < NV; ++i) S.v[i] = *(const LAS f32x4*)(vb + i * 1024 + t * 64);
  S.rv = buf[5120 + t * 16 + rw];
  if (SC) { S.s0 = buf[5376 + t]; S.s1 = buf[5392 + t]; } else { S.s0 = 0.f; S.s1 = 0.f; }
}
template <int MIX, int NV> __device__ __forceinline__ void scan_step(const StepV<NV>& c, float (&s)[4], float (&n)[4], float& myo, int kq, int t) {
  float o;
  if (MIX == 0) { const f32x4 f = c.v[0], k = c.v[1], q = c.v[2]; const float vj = c.rv; o = 0.f;
#pragma unroll
    for (int i = 0; i < 4; ++i) { s[i] = f[i] * s[i] + k[i] * vj; o += q[i] * s[i]; }
    o = allred16(o);
  } else if (MIX == 1) { const f32x4 w = c.v[0], kka = c.v[1], kd = c.v[2], kk = c.v[3], r = c.v[4]; const float vj = c.rv;
    float sa = 0.f;
#pragma unroll
    for (int i = 0; i < 4; ++i) sa += s[i] * kk[i];
    sa = allred16(sa); o = 0.f;
#pragma unroll
    for (int i = 0; i < 4; ++i) { s[i] = s[i] * w[i] + (vj * kd[i] - sa * kka[i]); o += s[i] * r[i]; }
    o = allred16(o);
  } else if (MIX == 2) { const f32x4 k = c.v[0], q = c.v[1]; const float vj = c.rv, a = c.s0, bt = c.s1;
    float u = 0.f;
#pragma unroll
    for (int i = 0; i < 4; ++i) u += k[i] * s[i];
    u = allred16(u) * a; const float cc = bt * (vj - u); o = 0.f;
#pragma unroll
    for (int i = 0; i < 4; ++i) { s[i] = a * s[i] + cc * k[i]; o += q[i] * s[i]; }
    o = allred16(o);
  } else { const f32x4 k = c.v[0], q = c.v[1]; const float vj = c.rv, f = c.s0, ig = c.s1;
    const float iv = ig * vj; float num = 0.f, den = 0.f;
#pragma unroll
    for (int i = 0; i < 4; ++i) { s[i] = f * s[i] + iv * k[i]; n[i] = f * n[i] + ig * k[i]; num += q[i] * s[i]; den += q[i] * n[i]; }
    num = allred16(num); den = allred16(den);
    o = num / fmaxf(fabsf(den), 1.0f);
  }
  myo = (kq == t) ? o : myo;
}
template <int MIX, int NV, bool SC> __device__ __forceinline__ float scan_chunk(const LAS float* buf, int lt, float (&s)[4], float (&n)[4]) {
  const int rw = lt >> 4, kq = lt & 15; float myo = 0.f;
  const LAS float* vb = buf + kq * 4;
  StepV<NV> A, B; ld_step<NV, SC>(A, vb, buf, 0, rw);
#pragma unroll 1
  for (int t = 0; t < 16; t += 2) {
    ld_step<NV, SC>(B, vb, buf, t + 1, rw); scan_step<MIX, NV>(A, s, n, myo, kq, t);
    ld_step<NV, SC>(A, vb, buf, t + 2, rw); scan_step<MIX, NV>(B, s, n, myo, kq, t + 1);
  }
  return myo;
}
__device__ __forceinline__ float scan_compute(const LAS float* buf, int mixer, int lt, float (&s)[4], float (&n)[4]) {
  if (mixer == 0) return scan_chunk<0, 3, false>(buf, lt, s, n);
  if (mixer == 1) return scan_chunk<1, 5, false>(buf, lt, s, n);
  if (mixer == 2) return scan_chunk<2, 2, true>(buf, lt, s, n);
  return scan_chunk<3, 2, true>(buf, lt, s, n);
}

__device__ void phase_scan(const KP& p, int layer, LAS float* lds) {
  const int tid = otid(), half = tid >> 8, lt = tid & 255;
  const int odd = layer & 1;
  LAS float* hb = lds + half * (2 * 5632);
  bf16_t* O = (bf16_t*)(p.ws + OFF_O);
  for (int pair = blockIdx.x; pair < 256; pair += gridDim.x) {
    const int item = half * 256 + pair, sub = item & 127;
#ifdef FORCE_MIXER
    const int mixer = FORCE_MIXER;
#else
    const int mixer = __builtin_amdgcn_readfirstlane(item >> 7);
#endif
    const int d = sub >> 6, b = (sub >> 4) & 3, h = (sub >> 2) & 3, rq = sub & 3;
    const int cm = (mixer < 2) ? odd : !odd;
    float ka[4] = {0.f, 0.f, 0.f, 0.f}, ib = 0.f, fb = 0.f;
    if (mixer == 1) { const float* k_a = p.in[I_RKA] + layer * 256 + h * 64 + (lt & 15) * 4; ka[0] = k_a[0]; ka[1] = k_a[1]; ka[2] = k_a[2]; ka[3] = k_a[3]; }
    if (mixer == 3) { ib = p.in[I_MIB][layer * 8 + d * 4 + h]; fb = p.in[I_MFB][layer * 8 + d * 4 + h]; }
    float s[4] = {0.f, 0.f, 0.f, 0.f}, n[4] = {0.f, 0.f, 0.f, 0.f};
    ScanRegs RA, RB;
    scan_load(RA, mixer, 0, d, b, h, rq, cm, lt, p); scan_load(RB, mixer, 1, d, b, h, rq, cm, lt, p);
    scan_stage(RA, hb, mixer, lt, ka, ib, fb);
    scan_load(RA, mixer, 2, d, b, h, rq, cm, lt, p);
    __syncthreads();
    bf16_t* Od = O + (size_t)d * NTOK * 1024 + mixer * 256 + h * 64 + rq * 16 + (lt >> 4);
    for (int c = 0; c < NCHUNK; c += 2) {
      scan_stage(RB, hb + 5632, mixer, lt, ka, ib, fb);
      scan_load(RB, mixer, c + 3, d, b, h, rq, cm, lt, p);
      { const float o = scan_compute(hb, mixer, lt, s, n); Od[(size_t)seq_row(c * 16 + (lt & 15), d, b, cm) * 1024] = f2bf(o); }
      __syncthreads();
      scan_stage(RA, hb, mixer, lt, ka, ib, fb);
      scan_load(RA, mixer, c + 4, d, b, h, rq, cm, lt, p);
      { const float o = scan_compute(hb + 5632, mixer, lt, s, n); Od[(size_t)seq_row((c + 1) * 16 + (lt & 15), d, b, cm) * 1024] = f2bf(o); }
      __syncthreads();
    }
  }
}

#ifndef PH_MASK
#define PH_MASK 0xFFFF
#endif
__global__ void __launch_bounds__(512, 2) mega(KP p) {
  extern __shared__ __attribute__((aligned(16))) unsigned char shm[];
  cg::grid_group grid = cg::this_grid();
  LAS unsigned char* lds = (LAS unsigned char*)shm;
  float* ldsf = (float*)shm;
  const int tid = threadIdx.x, gtid = blockIdx.x * 512 + tid, gsz = gridDim.x * 512;
  float* MOD = (float*)(p.ws + OFF_MOD);

  { const f32x4* xs = (const f32x4*)p.in[I_X]; f32x4* xd = (f32x4*)p.out;
    for (int i = gtid; i < NLAT * DM / 4; i += gsz) xd[i] = xs[i];
    const f32x4* cs = (const f32x4*)p.in[I_CTX]; f32x4* cd = (f32x4*)(p.ws + OFF_XC);
    for (int i = gtid; i < 1024 * DM / 4; i += gsz) cd[i] = cs[i];
    for (int i = tid; i < 5 * 1024; i += 512) { const float cv = i < 4096 ? p.in[I_C][i] : p.in[I_CCTX][i - 4096]; ldsf[i] = siluf_(cv); }
    __syncthreads();
    float* MODP = (float*)(p.ws + OFF_MODP);
    for (int g = gtid; g < NLAYER * 8 * 6144; g += gsz) { const int col = g % 6144, ks = (g / 6144) & 7, l = g / (6144 * 8);
      const float* w = p.in[I_ADAW] + ((size_t)l * 1024 + ks * 128) * 6144 + col; float a[5] = {0.f, 0.f, 0.f, 0.f, 0.f};
      for (int k = 0; k < 128; ++k) { const float wv = w[(size_t)k * 6144];
#pragma unroll
        for (int b = 0; b < 5; ++b) a[b] += ldsf[b * 1024 + ks * 128 + k] * wv; }
#pragma unroll
      for (int b = 0; b < 5; ++b) MODP[(((size_t)ks * NLAYER + l) * 5 + b) * 6144 + col] = a[b]; }
    if (gtid < 512) { const int dc = gtid; const float* gm = p.in[I_HGAMMA]; float e[4], mx = -1e30f, sum = 0.f;
      for (int l = 0; l < 4; ++l) mx = fmaxf(mx, gm[l * 512 + dc]);
      for (int l = 0; l < 4; ++l) { e[l] = __expf(gm[l * 512 + dc] - mx); sum += e[l]; }
      float* LB = (float*)(p.ws + OFF_LB); float cum = 0.f; LB[dc] = 0.f;
      for (int l = 1; l < 4; ++l) { cum += e[l] / sum; LB[l * 512 + dc] = cum; } }
    __syncthreads();
    phase_convert_weights(p, 0, ldsf);
  }
  grid.sync();
  { const float* MODP = (const float*)(p.ws + OFF_MODP);
    for (int i = gtid; i < NLAYER * 5 * 6144; i += gsz) { const int col = i % 6144, l = i / (5 * 6144); float a = p.in[I_ADAB][l * 6144 + col];
#pragma unroll
      for (int ks = 0; ks < 8; ++ks) a += MODP[(size_t)ks * NLAYER * 5 * 6144 + i];
      MOD[i] = a; } }
  grid.sync();
  phase_modulate(p, 0);
  grid.sync();

  for (int layer = 0; layer < NLAYER; ++layer) {
    const bool lastl = (layer == NLAYER - 1);
    const float* modl = MOD + (size_t)layer * 5 * 6144;
    pg8::StaticOrder S;
    if (PH_MASK & 1) { pg8::Gemm g{(const bf16_t*)(p.ws + OFF_HA), (const bf16_t*)(p.ws + OFF_WIN), NTOK, LDP, 1024};
      pg8::EpiB E{(bf16_t*)(p.ws + OFF_P), LDP, 0, (const float*)(p.ws + OFF_LB) + layer * 512, nullptr};
      S.init(g.M, g.N, gridDim.x, blockIdx.x); pg8::gemm_phase(lds, g, S, E); }
    grid.sync();
    if (PH_MASK & 2) phase_prep(p, layer);
    grid.sync();
    if (PH_MASK & 4) { pg8::Gemm g{(const bf16_t*)(p.ws + OFF_U), (const bf16_t*)(p.ws + OFF_WC), NTOK, 1280, 384};
      pg8::EpiB E{(bf16_t*)(p.ws + OFF_RP), 2304, 2, p.in[I_RW0] + layer * 512, p.in[I_RA0] + layer * 512};
      S.init(g.M, g.N, gridDim.x, blockIdx.x); pg8::gemm_phase(lds, g, S, E); }
    grid.sync();
    if (PH_MASK & 8) phase_scan(p, layer, (LAS float*)lds);
    grid.sync();
    const int nrows = lastl ? NLAT : NTOK;
    if (PH_MASK & 16) phase_finish(p, layer, nrows);
    grid.sync();
    if (PH_MASK & 32) { pg8::Gemm g{(const bf16_t*)(p.ws + OFF_YMIX), (const bf16_t*)(p.ws + OFF_WOUT), nrows, 1024, 1024};
      pg8::EpiR E{p.out, (float*)(p.ws + OFF_XC), modl + 2 * 1024};
      S.init(g.M, g.N, gridDim.x, blockIdx.x); pg8::gemm_phase(lds, g, S, E); }
    grid.sync();
    phase_ln(p, p.in[I_LN1G] + layer * 1024, p.in[I_LN1B] + layer * 1024, modl, 3 * 1024, nrows);
    grid.sync();
    if (PH_MASK & 64) { pg8::Gemm g{(const bf16_t*)(p.ws + OFF_HA), (const bf16_t*)(p.ws + OFF_W1), nrows, DFF, 1024};
      pg8::EpiB E{(bf16_t*)(p.ws + OFF_HID), DFF, 1, nullptr, nullptr};
      S.init(g.M, g.N, gridDim.x, blockIdx.x); pg8::gemm_phase(lds, g, S, E); }
    grid.sync();
    if (PH_MASK & 128) { pg8::Gemm g{(const bf16_t*)(p.ws + OFF_HID), (const bf16_t*)(p.ws + OFF_W2), nrows, 1024, DFF};
      pg8::EpiR E{p.out, (float*)(p.ws + OFF_XC), modl + 5 * 1024};
      S.init(g.M, g.N, gridDim.x, blockIdx.x); pg8::gemm_phase(lds, g, S, E); }
    grid.sync();
    phase_ln(p, p.in[I_LN2G] + layer * 1024, p.in[I_LN2B] + layer * 1024, lastl ? nullptr : modl + 5 * 6144, 0, nrows);
    if (!lastl) { __syncthreads(); phase_convert_weights(p, layer + 1, ldsf); grid.sync(); }
  }
}

extern "C" void kernel_launch(void* const* d_in, const int* in_sizes, int n_in, void* d_out, int out_size, void* d_ws, size_t ws_size, hipStream_t stream) {
  constexpr size_t kLds = pg8::STAGE_BYTES;
  static int grid = 0;
  if (!grid) {
    int dev = 0, cus = 0, per_cu = 0;
    hipGetDevice(&dev);
    hipDeviceGetAttribute(&cus, hipDeviceAttributeMultiprocessorCount, dev);
    hipFuncSetAttribute((const void*)mega, hipFuncAttributeMaxDynamicSharedMemorySize, (int)kLds);
    hipOccupancyMaxActiveBlocksPerMultiprocessor(&per_cu, (const void*)mega, 512, kLds);
    if (per_cu < 1) per_cu = 1;
    grid = cus * per_cu;
    if (grid > 256) grid = 256;
    if (ws_size < WS_END || n_in != 34) { fprintf(stderr, "kernel_launch: workspace %zu < %zu or n_in %d != 34\n", ws_size, (size_t)WS_END, n_in); grid = -1; }
  }
  if (grid < 0) return;
  KP p{};
  for (int i = 0; i < 34; ++i) p.in[i] = (const float*)d_in[i];
  p.out = (float*)d_out; p.ws = (unsigned char*)d_ws;
  void* args[] = {&p};
  hipError_t e = hipLaunchCooperativeKernel((const void*)mega, dim3(grid), dim3(512), args, kLds, stream);
  if (e != hipSuccess) fprintf(stderr, "cooperative launch failed: %s (grid %d)\n", hipGetErrorString(e), grid);
}
```

```cpp
#include <hip/hip_runtime.h>
#include <hip/hip_cooperative_groups.h>
#include <cstdio>
namespace cg = cooperative_groups;

#define LAS __attribute__((address_space(3)))
typedef unsigned short bf16_t;
typedef short bf16x8 __attribute__((ext_vector_type(8)));
typedef float f32x4 __attribute__((ext_vector_type(4)));
typedef unsigned u32x4 __attribute__((ext_vector_type(4)));
typedef unsigned u32x2 __attribute__((ext_vector_type(2)));

constexpr int NTOK = 17408, NLAT = 16384, DM = 1024, LDP = 4608, DIN = 4512, DFF = 4096, NLAYER = 4;
constexpr int NCHUNK = 272, XCD_BAR_WORDS_C = 3456;
constexpr float ALPHA = 1.681792830507429f;
enum { I_X = 0, I_C, I_CTX, I_CCTX, I_ADAW, I_ADAB, I_WIN, I_WOUT, I_LN1G, I_LN1B, I_LN2G, I_LN2B, I_W1, I_W2, I_HGAMMA, I_HNORM,
       I_RMU, I_RW0, I_RW2, I_RA0, I_RA2, I_RG2, I_RKK, I_RKA, I_RRK, I_RLNG, I_RLNB, I_GCONV, I_GALOG, I_GDT, I_GNORM, I_MIB, I_MFB, I_MNORM };
constexpr size_t al256(size_t x) { return (x + 255) & ~(size_t)255; }
constexpr size_t OFF_XC = 0;
constexpr size_t OFF_MOD = OFF_XC + (size_t)1024 * 1024 * 4;
constexpr size_t OFF_LB = OFF_MOD + al256((size_t)NLAYER * 5 * 6144 * 4);
constexpr size_t OFF_GS = OFF_LB + al256((size_t)NLAYER * 2 * 256 * 4);
constexpr size_t OFF_WIN = OFF_GS + al256((size_t)NTOK * 16 * 4);
constexpr size_t OFF_WOUT = OFF_WIN + (size_t)LDP * 1024 * 2;
constexpr size_t OFF_W1 = OFF_WOUT + (size_t)1024 * 1024 * 2;
constexpr size_t OFF_W2 = OFF_W1 + (size_t)4096 * 1024 * 2;
constexpr size_t OFF_WC = OFF_W2 + (size_t)4096 * 1024 * 2;
constexpr size_t OFF_P = OFF_WC + al256((size_t)1280 * 384 * 2);
constexpr size_t OFF_O = OFF_P + (size_t)NTOK * LDP * 2;
constexpr size_t OFF_RP = OFF_O + (size_t)2 * NTOK * 1024 * 2;
constexpr size_t OFF_GP = OFF_RP + (size_t)NTOK * 2304 * 2;
constexpr size_t WS_END = OFF_GP + (size_t)NTOK * 768 * 2;
constexpr size_t OFF_BAR = WS_END, WS_END2 = OFF_BAR + (size_t)XCD_BAR_WORDS_C * 4;
constexpr size_t OFF_YMIX = OFF_O, OFF_U = OFF_O, OFF_MODP = OFF_O, OFF_HA = OFF_O + (size_t)NTOK * 1024 * 2, OFF_HID = OFF_P;

struct KP { const float* in[34]; float* out; unsigned char* ws; };

__device__ __forceinline__ float bf2f(unsigned short b) { return __uint_as_float(((unsigned)b) << 16); }
__device__ __forceinline__ float bflo(unsigned u) { return __uint_as_float(u << 16); }
__device__ __forceinline__ float bfhi(unsigned u) { return __uint_as_float(u & 0xffff0000u); }
__device__ __forceinline__ unsigned cvt_pk_bf16(float lo, float hi) { unsigned r; asm volatile("v_cvt_pk_bf16_f32 %0, %1, %2" : "=v"(r) : "v"(lo), "v"(hi)); return r; }
__device__ __forceinline__ unsigned short f2bf(float f) { return (unsigned short)(cvt_pk_bf16(f, 0.f) & 0xffffu); }
template <int CTRL> __device__ __forceinline__ float dppf(float x) { return __builtin_bit_cast(float, __builtin_amdgcn_mov_dpp(__builtin_bit_cast(int, x), CTRL, 0xf, 0xf, true)); }
__device__ __forceinline__ float allred16(float x) { x += dppf<0x128>(x); x += dppf<0x124>(x); x += dppf<0x4E>(x); x += dppf<0xB1>(x); return x; }
__device__ __forceinline__ float allred64(float x) { x = allred16(x); x += __shfl_xor(x, 16); x += __shfl_xor(x, 32); return x; }
__device__ __forceinline__ float sigmoidf_(float x) { return 1.0f / (1.0f + __expf(-x)); }
__device__ __forceinline__ float siluf_(float x) { return x / (1.0f + __expf(-x)); }
__device__ __forceinline__ float softplusf_(float x) { return fmaxf(x, 0.f) + __logf(1.0f + __expf(-fabsf(x))); }
__device__ __forceinline__ int otid() { int t = threadIdx.x; asm volatile("" : "+v"(t)); return t; }
__device__ __forceinline__ float* xrow(const KP& p, int row) { return row < NLAT ? p.out + (size_t)row * DM : (float*)(p.ws + OFF_XC) + (size_t)(row - NLAT) * DM; }
__device__ __forceinline__ int cmperm(int n) { return ((n & 63) << 6) | (n >> 6); }
__device__ __forceinline__ int seq_row(int s, int d, int b, int cm) {
  if (s < 256) { const int p = d ? 255 - s : s; return NLAT + b * 256 + p; }
  const int q = s - 256, p = d ? 4095 - q : q; return b * 4096 + (cm ? cmperm(p) : p);
}
__device__ __forceinline__ int nbr_row(int r, int cm, int dp) {
  if (r >= NLAT) { const int q = r - NLAT, b = q >> 8, p = (q & 255) + dp; return (p < 0 || p > 255) ? -1 : NLAT + b * 256 + p; }
  const int b = r >> 12, n = r & 4095; int p = (cm ? cmperm(n) : n) + dp; if (p < 0 || p > 4095) return -1;
  return b * 4096 + (cm ? cmperm(p) : p);
}
__device__ __forceinline__ void unpack4(u32x2 u, float (&f)[4]) { f[0] = bflo(u.x); f[1] = bfhi(u.x); f[2] = bflo(u.y); f[3] = bfhi(u.y); }
__device__ __forceinline__ u32x2 pack4(const float (&f)[4]) { u32x2 u; u.x = cvt_pk_bf16(f[0], f[1]); u.y = cvt_pk_bf16(f[2], f[3]); return u; }


#define XB_TMO      128
#define XB_XCNT(j)  (256  + 64 * (j))
#define XB_XSUB(j)  (1280 + 64 * (j))
#define XB_XGEN(j)  (2304 + 64 * (j))
#define XB_TOP      3328
#define XB_TOPGEN   3392
#define XCD_BAR_WORDS 3456
#define XB_SPIN_CAP (1u << 18)
__device__ __forceinline__ unsigned xb_ld(unsigned* p)              { return __hip_atomic_load(p, __ATOMIC_RELAXED, __HIP_MEMORY_SCOPE_AGENT); }
__device__ __forceinline__ unsigned xb_add(unsigned* p, unsigned v) { return __hip_atomic_fetch_add(p, v, __ATOMIC_RELAXED, __HIP_MEMORY_SCOPE_AGENT); }
__device__ __forceinline__ unsigned xb_xcc_id() { return (unsigned)__builtin_amdgcn_s_getreg((3 << 11) | 20) & 0xFu; }
#define XB_SPIN(cond, bar) do { unsigned _sp = 0; while (cond) { __builtin_amdgcn_s_sleep(1); \
    if ((++_sp & 255u) == 0u) { if (xb_ld(&(bar)[XB_TMO])) break; if (_sp > XB_SPIN_CAP) { atomicAdd(&(bar)[XB_TMO], 1u); break; } } } } while (0)
struct XcdBarrier { unsigned* bar; unsigned x; volatile LAS unsigned* st; };
__device__ __forceinline__ XcdBarrier xcd_barrier_post(unsigned* bar, volatile LAS unsigned* st) {
    XcdBarrier b; b.bar = bar; b.x = xb_xcc_id(); b.st = st;
    if (threadIdx.x == 0) (void)xb_add(&bar[XB_XCNT(b.x)], 1u);
    return b;
}
__device__ __forceinline__ void xcd_barrier_complete(unsigned* bar, unsigned x, unsigned& nloc, unsigned& nx) {
    const unsigned G = gridDim.x * gridDim.y * gridDim.z;
    unsigned sum, cnt, mine, sp = 0u;
    for (;;) {
        sum = 0u; cnt = 0u; mine = 0u;
#pragma unroll
        for (unsigned j = 0; j < 16; ++j) { const unsigned c = xb_ld(&bar[XB_XCNT(j)]); sum += c; cnt += (c > 0u) ? 1u : 0u; mine = (j == x) ? c : mine; }
        if (sum == G) break;
        __builtin_amdgcn_s_sleep(1);
        if ((++sp & 255u) == 0u) { if (xb_ld(&bar[XB_TMO])) break; if (sp > XB_SPIN_CAP) { atomicAdd(&bar[XB_TMO], 1u); break; } }
    }
    nloc = mine > 0u ? mine : 1u; nx = cnt > 0u ? cnt : 1u;
}
__device__ __forceinline__ void xcd_barrier(const XcdBarrier& b) {
    asm volatile("s_waitcnt vmcnt(0)" ::: "memory");
    __syncthreads();
    if (threadIdx.x == 0) {
        unsigned* bar = b.bar;
        __builtin_amdgcn_s_waitcnt(0);
        unsigned nloc = b.st[0], nx = b.st[1];
        if (nloc == 0u) { xcd_barrier_complete(bar, b.x, nloc, nx); b.st[0] = nloc; b.st[1] = nx; }
        const unsigned old = xb_add(&bar[XB_XSUB(b.x)], 1u);
        const unsigned gen = old / nloc;
        if (old + 1u == (gen + 1u) * nloc) {
            __builtin_amdgcn_fence(__ATOMIC_RELEASE, "agent");
            asm volatile("s_waitcnt vmcnt(0)" ::: "memory");
            const unsigned og = xb_add(&bar[XB_TOP], 1u);
            const unsigned tg = og / nx;
            if (og + 1u == (tg + 1u) * nx) xb_add(&bar[XB_TOPGEN], 1u);
            else XB_SPIN(xb_ld(&bar[XB_TOPGEN]) == tg, bar);
            __builtin_amdgcn_fence(__ATOMIC_ACQUIRE, "agent");
            xb_add(&bar[XB_XGEN(b.x)], 1u);
            asm volatile("s_waitcnt vmcnt(0)" ::: "memory");
        } else {
            XB_SPIN(xb_ld(&bar[XB_XGEN(b.x)]) == gen, bar);
            __builtin_amdgcn_fence(__ATOMIC_ACQUIRE, "agent");
            asm volatile("s_waitcnt vmcnt(0)" ::: "memory");
        }
    }
    __syncthreads();
}

namespace pg8 {
constexpr int BM = 256, BK = 64, HALF = 128, HTB = HALF * BK * 2, STAGE_BYTES = 8 * HTB, NXCD = 8, WGM = 8;
__host__ __device__ __forceinline__ int lds_byte(int r, int c) { const int st = (r >> 4) * 2 + (c >> 5), rr = r & 15, cc = c & 31, ob = rr * 64 + cc * 2; return st * 1024 + (ob ^ (((ob >> 9) & 1) << 5)); }
__host__ __device__ __forceinline__ void stage_rc(int b, int& R, int& C) { const int st = b / 1024, sb = b % 1024, swz = sb ^ (((sb >> 9) & 1) << 5); R = (st >> 1) * 16 + swz / 64; C = (st & 1) * 32 + (swz % 64) / 2; }
__host__ __device__ __forceinline__ int perm32(int rho) { const int n = rho >> 4, i = rho & 15; return 8 * (i >> 2) + 4 * n + (i & 3); }
struct Unit { int pm, pn; };
struct Gemm { const bf16_t* A; const bf16_t* Bt; int M, N, K; };
struct StaticOrder {
  int nM, nN, nwg, G, c;
  __device__ void init(int M, int N, int G_, int c_) { nM = M / BM; nN = N / BM; nwg = nM * nN; G = G_; c = c_; }
  __device__ bool next(int i, Unit& u) const {
    const long L = (long)i * G + c; if (L >= nwg) return false;
    int wgid = (int)L; { const int q = nwg / NXCD, r = nwg % NXCD, xcd = wgid % NXCD, off = wgid / NXCD; wgid = (xcd < r ? xcd * (q + 1) : r * (q + 1) + (xcd - r) * q) + off; }
    const int nig = WGM * nN, gid = wgid / nig, fm = gid * WGM, gsz = (nM - fm) < WGM ? (nM - fm) : WGM;
    u.pm = fm + ((wgid % nig) % gsz); u.pn = (wgid % nig) / gsz; return true;
  }
};

template <class Epi>
__device__ __forceinline__ void gemm_phase(LAS unsigned char* lds, const Gemm g, const StaticOrder& S, const Epi& E) {
  const int tid = otid(), wid = __builtin_amdgcn_readfirstlane(tid >> 6), lane = tid & 63, wr = wid >> 2, wc = wid & 3, fr = lane & 15, fq = lane >> 4;
  int K = g.K; asm volatile("" : "+s"(K));
  const int nt = K / BK;
  unsigned voffA[2], voffB[2];
#pragma unroll
  for (int i = 0; i < 2; ++i) { int R, C; stage_rc(tid * 16 + i * 8192, R, C); const int Rb = Epi::PERM ? ((R & ~31) + perm32(R & 31)) : R;
    voffA[i] = (unsigned)(R * K + C) * 2u; voffB[i] = (unsigned)(Rb * K + C) * 2u; }
  const size_t kstep = (size_t)(BK * 2);
  const size_t hstep = (size_t)HALF * K * 2;
  const size_t tstep = 2 * hstep;
  const unsigned ldsw = (unsigned)wid * 1024u;
  const int aoff = lds_byte(wr * 64 + fr, fq * 8), boff = lds_byte(wc * 32 + fr, fq * 8);
#define PG8_SA(b, h) (((b) * 2 + (h)) * HTB)
#define PG8_SB(b, h) ((4 + (b) * 2 + (h)) * HTB)
#define PG8_STAGE(bufoff, gbase, voff) do { _Pragma("unroll") for (int _i = 0; _i < 2; ++_i) \
    __builtin_amdgcn_global_load_lds((const unsigned*)((const char*)(gbase) + (voff)[_i]), (LAS unsigned*)(lds + (bufoff) + ldsw + _i * 8192), 16, 0, 0); } while (0)
#define PG8_LDA(dst, b, h) do { _Pragma("unroll") for (int m = 0; m < 4; ++m) _Pragma("unroll") for (int k = 0; k < 2; ++k) dst[m][k] = *(const LAS bf16x8*)(lds + PG8_SA(b, h) + aoff + m * 2048 + k * 1024); } while (0)
#define PG8_LDB(dst, b, h) do { _Pragma("unroll") for (int n = 0; n < 2; ++n) _Pragma("unroll") for (int k = 0; k < 2; ++k) dst[n][k] = *(const LAS bf16x8*)(lds + PG8_SB(b, h) + boff + n * 2048 + k * 1024); } while (0)
#define PG8_MMA(ai, bj, At, Bt) do { __builtin_amdgcn_s_setprio(1); _Pragma("unroll") for (int m = 0; m < 4; ++m) _Pragma("unroll") for (int n = 0; n < 2; ++n) _Pragma("unroll") for (int k = 0; k < 2; ++k) \
    acc[ai][bj][m][n] = __builtin_amdgcn_mfma_f32_16x16x32_bf16(Bt[n][k], At[m][k], acc[ai][bj][m][n], 0, 0, 0); __builtin_amdgcn_s_setprio(0); } while (0)
#define PG8_WAIT_V(n) asm volatile("s_waitcnt vmcnt(" #n ")" ::: "memory")
#define PG8_WAIT_L(n) asm volatile("s_waitcnt lgkmcnt(" #n ")" ::: "memory")
#define PG8_BAR __builtin_amdgcn_s_barrier()
#define PG8_SCHED __builtin_amdgcn_sched_barrier(0)
  Unit cur, nxt; int ui = 0;
  if (!S.next(0, cur)) return;
  f32x4 acc[2][2][4][2];
#pragma unroll
  for (int a = 0; a < 2; ++a)
#pragma unroll
    for (int b = 0; b < 2; ++b)
#pragma unroll
      for (int m = 0; m < 4; ++m)
#pragma unroll
        for (int n = 0; n < 2; ++n) acc[a][b][m][n] = (f32x4){0.f, 0.f, 0.f, 0.f};
  bf16x8 At[4][2], B0[2][2], B1[2][2];
  const char* cA = (const char*)g.A + (size_t)cur.pm * tstep; const char* cB = (const char*)g.Bt + (size_t)cur.pn * tstep;
  PG8_STAGE(PG8_SB(0, 0), cB, voffB); PG8_STAGE(PG8_SA(0, 0), cA, voffA); PG8_STAGE(PG8_SB(0, 1), cB + hstep, voffB); PG8_STAGE(PG8_SA(0, 1), cA + hstep, voffA);
  if (wr == 1) PG8_BAR;
  PG8_WAIT_V(4); PG8_BAR;
  PG8_STAGE(PG8_SB(1, 0), cB + kstep, voffB); PG8_STAGE(PG8_SA(1, 0), cA + kstep, voffA); PG8_STAGE(PG8_SB(1, 1), cB + hstep + kstep, voffB);
  PG8_WAIT_V(6); PG8_BAR;
  for (;;) {
    const bool has_next = S.next(ui + 1, nxt);
    const char* nA = has_next ? (const char*)g.A + (size_t)nxt.pm * tstep : cA; const char* nB = has_next ? (const char*)g.Bt + (size_t)nxt.pn * tstep : cB;
    for (int t = 0; t < nt; t += 2) {
      const bool last = (t == nt - 2);
      const char* a1 = cA + (size_t)(t + 1) * kstep;
      const char* a2 = last ? nA : cA + (size_t)(t + 2) * kstep; const char* b2 = last ? nB : cB + (size_t)(t + 2) * kstep;
      const char* a3 = a2 + kstep; const char* b3 = b2 + kstep;
      PG8_LDB(B0, 0, 0); PG8_SCHED; PG8_LDA(At, 0, 0); PG8_STAGE(PG8_SA(1, 1), a1 + hstep, voffA);
      PG8_WAIT_L(8); PG8_BAR; PG8_WAIT_L(0); PG8_MMA(0, 0, At, B0); PG8_BAR; PG8_SCHED;
      PG8_LDB(B1, 0, 1); PG8_STAGE(PG8_SB(0, 0), b2, voffB);
      PG8_BAR; PG8_WAIT_L(0); PG8_MMA(0, 1, At, B1); PG8_BAR;
      PG8_LDA(At, 0, 1); PG8_STAGE(PG8_SA(0, 0), a2, voffA);
      PG8_BAR; PG8_WAIT_L(0); PG8_MMA(1, 0, At, B0); PG8_BAR; PG8_SCHED;
      PG8_STAGE(PG8_SB(0, 1), b2 + hstep, voffB);
      PG8_WAIT_V(6); PG8_BAR; PG8_MMA(1, 1, At, B1); PG8_BAR;
      PG8_LDB(B0, 1, 0); PG8_SCHED; PG8_LDA(At, 1, 0); PG8_STAGE(PG8_SA(0, 1), a2 + hstep, voffA);
      PG8_WAIT_L(8); PG8_BAR; PG8_WAIT_L(0); PG8_MMA(0, 0, At, B0); PG8_BAR; PG8_SCHED;
      PG8_LDB(B1, 1, 1); PG8_STAGE(PG8_SB(1, 0), b3, voffB);
      PG8_BAR; PG8_WAIT_L(0); PG8_MMA(0, 1, At, B1); PG8_BAR;
      PG8_LDA(At, 1, 1); PG8_STAGE(PG8_SA(1, 0), a3, voffA);
      PG8_BAR; PG8_WAIT_L(0); PG8_MMA(1, 0, At, B0); PG8_BAR; PG8_SCHED;
      PG8_STAGE(PG8_SB(1, 1), b3 + hstep, voffB);
      PG8_WAIT_V(6); PG8_BAR; PG8_MMA(1, 1, At, B1); PG8_BAR;
    }
    E(acc, cur, wr, wc, fr, fq);
    if (!has_next) break;
#pragma unroll
    for (int a = 0; a < 2; ++a)
#pragma unroll
      for (int b = 0; b < 2; ++b)
#pragma unroll
        for (int m = 0; m < 4; ++m)
#pragma unroll
          for (int n = 0; n < 2; ++n) acc[a][b][m][n] = (f32x4){0.f, 0.f, 0.f, 0.f};
    cur = nxt; cA = nA; cB = nB; ++ui;
  }
  PG8_WAIT_V(0);
  if (wr == 0) PG8_BAR;
  PG8_BAR;
#undef PG8_SA
#undef PG8_SB
#undef PG8_STAGE
#undef PG8_LDA
#undef PG8_LDB
#undef PG8_MMA
#undef PG8_WAIT_V
#undef PG8_WAIT_L
#undef PG8_BAR
#undef PG8_SCHED
}

struct EpiB {
  static constexpr bool PERM = true;
  bf16_t* O; int ldc; int mode; const float* aux0; const float* aux1;
  __device__ __forceinline__ void operator()(const f32x4 (&acc)[2][2][4][2], const Unit& u, int wr, int wc, int fr, int fq) const {
    const int row0 = u.pm * BM + wr * 64 + fr;
    const int cin = wc * 32 + 8 * fq;
    const int col0 = (mode == 2 ? 1024 : 0) + u.pn * BM + cin;
    const bool special = (mode == 0) ? (u.pn == 2 || u.pn == 3) : (mode == 2 ? (u.pn < 4) : false);
    const float* auxp = nullptr;
    if (mode == 0) auxp = aux0 + ((u.pn - 2) & 1) * 256 + cin;
    if (mode == 2) auxp = (u.pn < 2 ? aux0 : aux1) + (u.pn & 1) * 256 + cin;
#pragma unroll
    for (int ai = 0; ai < 2; ++ai)
#pragma unroll
      for (int m = 0; m < 4; ++m) {
        bf16_t* rowp = O + (size_t)(row0 + ai * HALF + m * 16) * ldc + col0;
#pragma unroll
        for (int bj = 0; bj < 2; ++bj) {
          float v[8];
#pragma unroll
          for (int j = 0; j < 4; ++j) { v[j] = acc[ai][bj][m][0][j]; v[4 + j] = acc[ai][bj][m][1][j]; }
          if (mode == 1) {
#pragma unroll
            for (int j = 0; j < 8; ++j) { const float r = fmaxf(v[j], 0.f); v[j] = r * r; }
          } else if (special) {
            const f32x4 x0 = *(const f32x4*)(auxp + bj * HALF), x1 = *(const f32x4*)(auxp + bj * HALF + 4);
            if (mode == 0) {
#pragma unroll
              for (int j = 0; j < 4; ++j) { v[j] = (1.0f - x0[j]) / (1.0f + __expf(v[j])); v[4 + j] = (1.0f - x1[j]) / (1.0f + __expf(v[4 + j])); }
            } else {
#pragma unroll
              for (int j = 0; j < 4; ++j) { v[j] += x0[j]; v[4 + j] += x1[j]; }
            }
          }
          u32x4 w; w.x = cvt_pk_bf16(v[0], v[1]); w.y = cvt_pk_bf16(v[2], v[3]); w.z = cvt_pk_bf16(v[4], v[5]); w.w = cvt_pk_bf16(v[6], v[7]);
          *(u32x4*)(rowp + bj * HALF) = w;
        }
      }
  }
};
struct EpiR {
  static constexpr bool PERM = false;
  float* xlat; float* xctx; const float* gate;
  __device__ __forceinline__ void operator()(const f32x4 (&acc)[2][2][4][2], const Unit& u, int wr, int wc, int fr, int fq) const {
    const int row0 = u.pm * BM + wr * 64 + fr, col0 = u.pn * BM + wc * 32 + 4 * fq;
    const int b5 = (u.pm < 64) ? (u.pm >> 4) : 4;
    f32x4 gv[2][2];
#pragma unroll
    for (int bj = 0; bj < 2; ++bj)
#pragma unroll
      for (int n = 0; n < 2; ++n) gv[bj][n] = *(const f32x4*)(gate + (size_t)b5 * 6144 + col0 + bj * HALF + n * 16);
#pragma unroll
    for (int ai = 0; ai < 2; ++ai)
#pragma unroll
      for (int m = 0; m < 4; ++m) {
        const int row = row0 + ai * HALF + m * 16;
        float* rowp = (row < NLAT ? xlat + (size_t)row * DM : xctx + (size_t)(row - NLAT) * DM) + col0;
#pragma unroll
        for (int bj = 0; bj < 2; ++bj)
#pragma unroll
          for (int n = 0; n < 2; ++n) { f32x4 xv = *(f32x4*)(rowp + bj * HALF + n * 16); xv = xv * ALPHA + gv[bj][n] * acc[ai][bj][m][n]; *(f32x4*)(rowp + bj * HALF + n * 16) = xv; }
      }
  }
};
}

__device__ __forceinline__ void phase_convert_weights(const KP& p, int layer, float* tile  ) {
  const int tid = otid();
  bf16_t* dWIN = (bf16_t*)(p.ws + OFF_WIN); bf16_t* dWOUT = (bf16_t*)(p.ws + OFF_WOUT); bf16_t* dW1 = (bf16_t*)(p.ws + OFF_W1); bf16_t* dW2 = (bf16_t*)(p.ws + OFF_W2);
  for (int T = blockIdx.x; T < 3456; T += gridDim.x) {
    const float* src; bf16_t* dst; int K, N, t;
    if (T < 1152) { t = T; src = p.in[I_WIN] + (size_t)layer * 1024 * DIN; dst = dWIN; K = 1024; N = DIN; }
    else if (T < 1408) { t = T - 1152; src = p.in[I_WOUT] + (size_t)layer * 1024 * 1024; dst = dWOUT; K = 1024; N = 1024; }
    else if (T < 2432) { t = T - 1408; src = p.in[I_W1] + (size_t)layer * 1024 * DFF; dst = dW1; K = 1024; N = DFF; }
    else { t = T - 2432; src = p.in[I_W2] + (size_t)layer * DFF * 1024; dst = dW2; K = DFF; N = 1024; }
    const int nk = K / 64, tk = t % nk, tn = t / nk;
    { const int j = tid & 63, i0 = tid >> 6;
#pragma unroll
      for (int ii = 0; ii < 8; ++ii) { const int i = i0 + ii * 8; const int n = tn * 64 + j; tile[i * 65 + j] = (n < N) ? src[(size_t)(tk * 64 + i) * N + n] : 0.f; } }
    __syncthreads();
    { const int i2 = (tid & 31) * 2, j0 = tid >> 5;
#pragma unroll
      for (int jj = 0; jj < 4; ++jj) { const int j = j0 + jj * 16; *(unsigned*)(dst + (size_t)(tn * 64 + j) * K + tk * 64 + i2) = cvt_pk_bf16(tile[i2 * 65 + j], tile[(i2 + 1) * 65 + j]); } }
    __syncthreads();
  }
  bf16_t* dWC = (bf16_t*)(p.ws + OFF_WC);
  const float* w2 = p.in[I_RW2] + (size_t)layer * 2 * 64 * 256; const float* a2 = p.in[I_RA2] + (size_t)layer * 2 * 64 * 256; const float* g2 = p.in[I_RG2] + (size_t)layer * 128 * 256;
  for (int idx = blockIdx.x * 512 + tid; idx < 1280 * 384; idx += gridDim.x * 512) {
    const int n = idx / 384, kk = idx % 384, seg = n >> 8, c = n & 255; float v = 0.f;
    if (seg < 2) { if ((kk >> 6) == seg) v = w2[((size_t)seg * 64 + (kk & 63)) * 256 + c]; }
    else if (seg < 4) { if ((kk >> 6) == seg) v = a2[((size_t)(seg - 2) * 64 + (kk & 63)) * 256 + c]; }
    else { if (kk >= 256) v = g2[(size_t)(kk - 256) * 256 + c]; }
    dWC[idx] = f2bf(v);
  }
}

__device__ __forceinline__ void phase_modulate(const KP& p, int layer) {
  const int tid_ = otid(), lane = tid_ & 63, wave = tid_ >> 6;
  const float* mod = (const float*)(p.ws + OFF_MOD) + (size_t)layer * 5 * 6144;
  bf16_t* HA = (bf16_t*)(p.ws + OFF_HA);
  for (int row = blockIdx.x * 8 + wave; row < NTOK; row += gridDim.x * 8) {
    const float* xr = xrow(p, row); const int b5 = row < NLAT ? row >> 12 : 4; const float* mb = mod + (size_t)b5 * 6144;
#pragma unroll
    for (int q = 0; q < 4; ++q) { const int c = q * 256 + lane * 4; const f32x4 xv = *(const f32x4*)(xr + c), sh = *(const f32x4*)(mb + c), sc = *(const f32x4*)(mb + 1024 + c);
      float y[4];
#pragma unroll
      for (int j = 0; j < 4; ++j) y[j] = xv[j] * (1.0f + sc[j]) + sh[j];
      *(u32x2*)(HA + (size_t)row * DM + c) = pack4(y); }
  }
}

__device__ __forceinline__ void phase_ln(const KP& p, const float* g, const float* bta, const float* mod_next, int sh_off, int nrows) {
  const int tid_ = otid(), lane = tid_ & 63, wave = tid_ >> 6;
  bf16_t* HA = (bf16_t*)(p.ws + OFF_HA);
  for (int row = blockIdx.x * 8 + wave; row < nrows; row += gridDim.x * 8) {
    float* xr = xrow(p, row); const int b5 = row < NLAT ? row >> 12 : 4;
    f32x4 v[4]; float s = 0.f;
#pragma unroll
    for (int q = 0; q < 4; ++q) { v[q] = *(const f32x4*)(xr + q * 256 + lane * 4); s += v[q][0] + v[q][1] + v[q][2] + v[q][3]; }
    const float mu = allred64(s) * (1.0f / 1024.0f);
    float s2 = 0.f;
#pragma unroll
    for (int q = 0; q < 4; ++q)
#pragma unroll
      for (int j = 0; j < 4; ++j) { v[q][j] -= mu; s2 += v[q][j] * v[q][j]; }
    const float rstd = rsqrtf(allred64(s2) * (1.0f / 1024.0f) + 1e-5f);
#pragma unroll
    for (int q = 0; q < 4; ++q) { const int c = q * 256 + lane * 4; const f32x4 gg = *(const f32x4*)(g + c), bb = *(const f32x4*)(bta + c);
      f32x4 y;
#pragma unroll
      for (int j = 0; j < 4; ++j) y[j] = v[q][j] * rstd * gg[j] + bb[j];
      *(f32x4*)(xr + c) = y;
      if (mod_next) { const float* mb = mod_next + (size_t)b5 * 6144 + sh_off; const f32x4 sh = *(const f32x4*)(mb + c), sc = *(const f32x4*)(mb + 1024 + c);
        float h[4];
#pragma unroll
        for (int j = 0; j < 4; ++j) h[j] = y[j] * (1.0f + sc[j]) + sh[j];
        *(u32x2*)(HA + (size_t)row * DM + c) = pack4(h); } }
  }
}

__device__ __forceinline__ void phase_prep(const KP& p, int layer) {
  const int tid_ = otid(), lane = tid_ & 63, wave = tid_ >> 6;
  const int odd = layer & 1, cmB = odd, cmC = !odd;
  const bf16_t* P = (const bf16_t*)(p.ws + OFF_P); bf16_t* RP = (bf16_t*)(p.ws + OFF_RP); bf16_t* GP = (bf16_t*)(p.ws + OFF_GP); bf16_t* U = (bf16_t*)(p.ws + OFF_U);
  float* GS = (float*)(p.ws + OFF_GS);
  const float* mu = p.in[I_RMU] + (size_t)layer * 1152; const float* k_k = p.in[I_RKK] + (size_t)layer * 256;
  const float* conv = p.in[I_GCONV] + (size_t)layer * 5 * 768;
  for (int row = blockIdx.x * 8 + wave; row < NTOK; row += gridDim.x * 8) {
    { const int rm = nbr_row(row, cmB, -1), rp = nbr_row(row, cmB, +1);
      const bf16_t* b0 = P + (size_t)row * LDP + 1280; const bf16_t* bm = rm >= 0 ? P + (size_t)rm * LDP + 1280 : nullptr; const bf16_t* bp = rp >= 0 ? P + (size_t)rp * LDP + 1280 : nullptr;
#pragma unroll
      for (int seg = 0; seg < 3; ++seg) { const int c = seg * 256 + lane * 4; float x0[4], xm[4] = {0.f, 0.f, 0.f, 0.f}, xp[4] = {0.f, 0.f, 0.f, 0.f}, y[4];
        unpack4(*(const u32x2*)(b0 + c), x0); if (bm) unpack4(*(const u32x2*)(bm + c), xm); if (bp) unpack4(*(const u32x2*)(bp + c), xp);
        const f32x4 m4 = *(const f32x4*)(mu + c);
#pragma unroll
        for (int j = 0; j < 4; ++j) y[j] = x0[j] + m4[j] * (0.5f * (xm[j] + xp[j]) - x0[j]);
        *(u32x2*)(RP + (size_t)row * 2304 + c) = pack4(y);
        if (seg == 1) { const f32x4 kk4 = *(const f32x4*)(k_k + lane * 4); float t[4], ss = 0.f;
#pragma unroll
          for (int j = 0; j < 4; ++j) { t[j] = y[j] * kk4[j]; ss += t[j] * t[j]; }
          const float rn = rsqrtf(allred16(ss) + 1e-12f);
#pragma unroll
          for (int j = 0; j < 4; ++j) t[j] *= rn;
          *(u32x2*)(RP + (size_t)row * 2304 + 768 + lane * 4) = pack4(t); } }
#pragma unroll
      for (int seg = 0; seg < 3; ++seg) { const int c = 768 + seg * 128 + lane * 2;
        const unsigned u0 = *(const unsigned*)(b0 + c), um = bm ? *(const unsigned*)(bm + c) : 0u, up = bp ? *(const unsigned*)(bp + c) : 0u;
        float y0 = bflo(u0), y1 = bfhi(u0);
        y0 = y0 + mu[c] * (0.5f * (bflo(um) + bflo(up)) - y0); y1 = y1 + mu[c + 1] * (0.5f * (bfhi(um) + bfhi(up)) - y1);
        if (seg == 0) { y0 = tanhf(y0); y1 = tanhf(y1); } else if (seg == 2) { y0 = sigmoidf_(y0); y1 = sigmoidf_(y1); }
        *(unsigned*)(U + (size_t)row * 384 + seg * 128 + lane * 2) = cvt_pk_bf16(y0, y1); } }
    { const bf16_t* br[5];
#pragma unroll
      for (int j = 0; j < 5; ++j) { const int rj = (j == 2) ? row : nbr_row(row, cmC, j - 2); br[j] = rj >= 0 ? P + (size_t)rj * LDP + 2432 : nullptr; }
#pragma unroll
      for (int seg = 0; seg < 3; ++seg) { const int c = seg * 256 + lane * 4; float a[4] = {0.f, 0.f, 0.f, 0.f};
#pragma unroll
        for (int j = 0; j < 5; ++j) if (br[j]) { float xv[4]; unpack4(*(const u32x2*)(br[j] + c), xv); const f32x4 w4 = *(const f32x4*)(conv + j * 768 + c);
#pragma unroll
          for (int e = 0; e < 4; ++e) a[e] += xv[e] * w4[e]; }
        float ss = 0.f;
#pragma unroll
        for (int e = 0; e < 4; ++e) { a[e] = siluf_(a[e]); ss += a[e] * a[e]; }
        if (seg < 2) { const float rn = rsqrtf(allred16(ss) + 1e-12f) * (seg == 0 ? 0.125f : 1.0f);
#pragma unroll
          for (int e = 0; e < 4; ++e) a[e] *= rn; }
        *(u32x2*)(GP + (size_t)row * 768 + c) = pack4(a); }
      if (lane < 16) { const int dh = lane & 7; float val;
        if (lane < 8) val = sigmoidf_(bf2f(P[(size_t)row * LDP + 3200 + dh]));
        else { const float la = -__expf(p.in[I_GALOG][layer * 8 + dh]) * softplusf_(bf2f(P[(size_t)row * LDP + 3208 + dh]) + p.in[I_GDT][layer * 8 + dh]); val = __expf(la); }
        GS[(size_t)row * 16 + lane] = val; } }
  }
}

__device__ __forceinline__ void phase_finish(const KP& p, int layer, int nrows) {
  const int tid_ = otid(), lane = tid_ & 63, wave = tid_ >> 6;
  const bf16_t* P = (const bf16_t*)(p.ws + OFF_P); const bf16_t* RP = (const bf16_t*)(p.ws + OFF_RP);
  bf16_t* O0 = (bf16_t*)(p.ws + OFF_O); const bf16_t* O1 = O0 + (size_t)NTOK * 1024;
  const float* hn = p.in[I_HNORM] + layer * 256; const float* gn = p.in[I_GNORM] + layer * 256; const float* mn = p.in[I_MNORM] + layer * 256;
  const float* lng = p.in[I_RLNG] + layer * 256; const float* lnb = p.in[I_RLNB] + layer * 256; const float* k_a = p.in[I_RKA] + layer * 256; const float* r_k = p.in[I_RRK] + layer * 256;
  const int c = lane * 4;
  for (int row = blockIdx.x * 8 + wave; row < nrows; row += gridDim.x * 8) {
    float o[4][4];
#pragma unroll
    for (int g = 0; g < 4; ++g) { float a[4], b[4]; unpack4(*(const u32x2*)(O0 + (size_t)row * 1024 + g * 256 + c), a); unpack4(*(const u32x2*)(O1 + (size_t)row * 1024 + g * 256 + c), b);
#pragma unroll
      for (int j = 0; j < 4; ++j) o[g][j] = a[j] + b[j]; }
    const bf16_t* pr = P + (size_t)row * LDP; const bf16_t* rr = RP + (size_t)row * 2304;
#pragma unroll
    for (int g = 0; g < 4; ++g) { if (g == 1) continue;
      float ss = 0.f;
#pragma unroll
      for (int j = 0; j < 4; ++j) ss += o[g][j] * o[g][j];
      const float rn = rsqrtf(allred16(ss) * (1.0f / 64.0f) + 1e-6f);
      const float* ng = g == 0 ? hn : (g == 2 ? gn : mn); const int gcol = g == 0 ? 1024 : (g == 2 ? 3216 : 4256);
      float gt[4]; unpack4(*(const u32x2*)(pr + gcol + c), gt); const f32x4 n4 = *(const f32x4*)(ng + c);
      float y[4];
#pragma unroll
      for (int j = 0; j < 4; ++j) y[j] = o[g][j] * rn * n4[j] * (g == 3 ? sigmoidf_(gt[j]) : siluf_(gt[j]));
      *(u32x2*)(O0 + (size_t)row * 1024 + g * 256 + c) = pack4(y); }
    { float s = o[1][0] + o[1][1] + o[1][2] + o[1][3];
      const float mu = allred16(s) * (1.0f / 64.0f); float s2 = 0.f;
#pragma unroll
      for (int j = 0; j < 4; ++j) { o[1][j] -= mu; s2 += o[1][j] * o[1][j]; }
      const float rstd = rsqrtf(allred16(s2) * (1.0f / 64.0f) + 64e-5f);
      float r4[4], k4[4], v4[4], af[4], ab[4], gt[4];
      unpack4(*(const u32x2*)(rr + c), r4); unpack4(*(const u32x2*)(rr + 256 + c), k4); unpack4(*(const u32x2*)(rr + 512 + c), v4);
      unpack4(*(const u32x2*)(rr + 1536 + c), af); unpack4(*(const u32x2*)(rr + 1792 + c), ab); unpack4(*(const u32x2*)(rr + 2048 + c), gt);
      const f32x4 ka4 = *(const f32x4*)(k_a + c), rk4 = *(const f32x4*)(r_k + c), g4 = *(const f32x4*)(lng + c), b4 = *(const f32x4*)(lnb + c);
      float bs = 0.f;
#pragma unroll
      for (int j = 0; j < 4; ++j) { const float a0 = sigmoidf_(af[j]), a1 = sigmoidf_(ab[j]); bs += r4[j] * k4[j] * rk4[j] * ((1.0f + (a0 - 1.0f) * ka4[j]) + (1.0f + (a1 - 1.0f) * ka4[j])); }
      bs = allred16(bs);
      float y[4];
#pragma unroll
      for (int j = 0; j < 4; ++j) y[j] = (o[1][j] * rstd * g4[j] + b4[j] + bs * v4[j]) * gt[j];
      *(u32x2*)(O0 + (size_t)row * 1024 + 256 + c) = pack4(y); }
  }
}

struct ScanRegs { u32x2 r[5]; unsigned short rv; unsigned short s0, s1; };

__device__ __forceinline__ void scan_load(ScanRegs& R, int mixer, int chunk, int d, int b, int h, int rq, int cm, int lt, const KP& p) {
  if (chunk > NCHUNK - 1) chunk = NCHUNK - 1;
  const int st = lt >> 4, cq = lt & 15;
  const int row = seq_row(chunk * 16 + st, d, b, cm);
  const bf16_t* P = (const bf16_t*)(p.ws + OFF_P);
  if (mixer == 0) { const bf16_t* base = P + (size_t)row * LDP;
    R.r[0] = *(const u32x2*)(base + 512 + d * 256 + h * 64 + cq * 4); R.r[1] = *(const u32x2*)(base + h * 64 + cq * 4); R.rv = base[256 + h * 64 + rq * 16 + cq]; }
  else if (mixer == 1) { const bf16_t* base = (const bf16_t*)(p.ws + OFF_RP) + (size_t)row * 2304 + h * 64 + cq * 4;
    R.r[0] = *(const u32x2*)(base + 1024 + d * 256); R.r[1] = *(const u32x2*)(base + 1536 + d * 256); R.r[2] = *(const u32x2*)(base + 256); R.r[3] = *(const u32x2*)(base + 768); R.r[4] = *(const u32x2*)(base);
    R.rv = ((const bf16_t*)(p.ws + OFF_RP))[(size_t)row * 2304 + 512 + h * 64 + rq * 16 + cq]; }
  else if (mixer == 2) { const bf16_t* base = (const bf16_t*)(p.ws + OFF_GP) + (size_t)row * 768;
    R.r[0] = *(const u32x2*)(base + 256 + h * 64 + cq * 4); R.r[1] = *(const u32x2*)(base + h * 64 + cq * 4); R.rv = base[512 + h * 64 + rq * 16 + cq];
    if (cq == 0) { const float* gs = (const float*)(p.ws + OFF_GS) + (size_t)row * 16; R.r[2].x = __float_as_uint(gs[8 + d * 4 + h]); R.r[2].y = __float_as_uint(gs[d * 4 + h]); } }
  else { const bf16_t* base = P + (size_t)row * LDP + 3472;
    R.r[0] = *(const u32x2*)(base + 256 + h * 64 + cq * 4); R.r[1] = *(const u32x2*)(base + h * 64 + cq * 4); R.rv = base[512 + h * 64 + rq * 16 + cq];
    if (cq == 0) { R.s0 = base[768 + d * 4 + h]; R.s1 = base[776 + d * 4 + h]; } }
}
__device__ __forceinline__ void scan_stage(const ScanRegs& R, LAS float* buf, int mixer, int lt, const float (&ka)[4], float ib, float fb) {
  const int st = lt >> 4, cq = lt & 15; LAS float* v0 = buf + st * 64 + cq * 4;
  float a[4], b[4];
  if (mixer == 0) { unpack4(R.r[0], a); unpack4(R.r[1], b);
    *(LAS f32x4*)(v0) = (f32x4){1.0f - a[0], 1.0f - a[1], 1.0f - a[2], 1.0f - a[3]}; *(LAS f32x4*)(v0 + 1024) = (f32x4){a[0], a[1], a[2], a[3]}; *(LAS f32x4*)(v0 + 2048) = (f32x4){b[0], b[1], b[2], b[3]}; }
  else if (mixer == 1) { float wl[4], aa[4], k[4], kk[4], r[4]; unpack4(R.r[0], wl); unpack4(R.r[1], aa); unpack4(R.r[2], k); unpack4(R.r[3], kk); unpack4(R.r[4], r);
    #pragma unroll
    for (int j = 0; j < 4; ++j) { wl[j] = __expf(-__expf(-softplusf_(-wl[j]) - 0.5f)); aa[j] = sigmoidf_(aa[j]); }
    *(LAS f32x4*)(v0) = (f32x4){wl[0], wl[1], wl[2], wl[3]};
    *(LAS f32x4*)(v0 + 1024) = (f32x4){kk[0] * aa[0], kk[1] * aa[1], kk[2] * aa[2], kk[3] * aa[3]};
    *(LAS f32x4*)(v0 + 2048) = (f32x4){k[0] * (1.0f + (aa[0] - 1.0f) * ka[0]), k[1] * (1.0f + (aa[1] - 1.0f) * ka[1]), k[2] * (1.0f + (aa[2] - 1.0f) * ka[2]), k[3] * (1.0f + (aa[3] - 1.0f) * ka[3])};
    *(LAS f32x4*)(v0 + 3072) = (f32x4){kk[0], kk[1], kk[2], kk[3]}; *(LAS f32x4*)(v0 + 4096) = (f32x4){r[0], r[1], r[2], r[3]}; }
  else if (mixer == 2) { unpack4(R.r[0], a); unpack4(R.r[1], b);
    *(LAS f32x4*)(v0) = (f32x4){a[0], a[1], a[2], a[3]}; *(LAS f32x4*)(v0 + 1024) = (f32x4){b[0], b[1], b[2], b[3]};
    if (cq == 0) { buf[5376 + st] = __uint_as_float(R.r[2].x); buf[5392 + st] = __uint_as_float(R.r[2].y); } }
  else { unpack4(R.r[0], a); unpack4(R.r[1], b);
    *(LAS f32x4*)(v0) = (f32x4){a[0] * 0.125f, a[1] * 0.125f, a[2] * 0.125f, a[3] * 0.125f}; *(LAS f32x4*)(v0 + 1024) = (f32x4){b[0], b[1], b[2], b[3]};
    if (cq == 0) { buf[5376 + st] = sigmoidf_(bf2f(R.s1) + fb); buf[5392 + st] = __expf(bf2f(R.s0) + ib); } }
  buf[5120 + lt] = bf2f(R.rv);
}
template <int NV> struct StepV { f32x4 v[NV]; float rv, s0, s1; };
template <int NV, bool SC> __device__ __forceinline__ void ld_step(StepV<NV>& S, const LAS float* vb, const LAS float* buf, int t, int rw) {
#pragma unroll
  for (int i = 0; i < NV; ++i) S.v[i] = *(const LAS f32x4*)(vb + i * 1024 + t * 64);
  S.rv = buf[5120 + t * 16 + rw];
  if (SC) { S.s0 = buf[5376 + t]; S.s1 = buf[5392 + t]; } else { S.s0 = 0.f; S.s1 = 0.f; }
}
template <int MIX, int NV> __device__ __forceinline__ void scan_step(const StepV<NV>& c, float (&s)[4], float (&n)[4], float& myo, int kq, int t) {
  float o;
  if (MIX == 0) { const f32x4 f = c.v[0], k = c.v[1], q = c.v[2]; const float vj = c.rv; o = 0.f;
#pragma unroll
    for (int i = 0; i < 4; ++i) { s[i] = f[i] * s[i] + k[i] * vj; o += q[i] * s[i]; }
    o = allred16(o);
  } else if (MIX == 1) { const f32x4 w = c.v[0], kka = c.v[1], kd = c.v[2], kk = c.v[3], r = c.v[4]; const float vj = c.rv;
    float sa = 0.f;
#pragma unroll
    for (int i = 0; i < 4; ++i) sa += s[i] * kk[i];
    sa = allred16(sa); o = 0.f;
#pragma unroll
    for (int i = 0; i < 4; ++i) { s[i] = s[i] * w[i] + (vj * kd[i] - sa * kka[i]); o += s[i] * r[i]; }
    o = allred16(o);
  } else if (MIX == 2) { const f32x4 k = c.v[0], q = c.v[1]; const float vj = c.rv, a = c.s0, bt = c.s1;
    float u = 0.f;
#pragma unroll
    for (int i = 0; i < 4; ++i) u += k[i] * s[i];
    u = allred16(u) * a; const float cc = bt * (vj - u); o = 0.f;
#pragma unroll
    for (int i = 0; i < 4; ++i) { s[i] = a * s[i] + cc * k[i]; o += q[i] * s[i]; }
    o = allred16(o);
  } else { const f32x4 k = c.v[0], q = c.v[1]; const float vj = c.rv, f = c.s0, ig = c.s1;
    const float iv = ig * vj; float num = 0.f, den = 0.f;
#pragma unroll
    for (int i = 0; i < 4; ++i) { s[i] = f * s[i] + iv * k[i]; n[i] = f * n[i] + ig * k[i]; num += q[i] * s[i]; den += q[i] * n[i]; }
    num = allred16(num); den = allred16(den);
    o = num / fmaxf(fabsf(den), 1.0f);
  }
  myo = (kq == t) ? o : myo;
}
template <int MIX, int NV, bool SC> __device__ __forceinline__ float scan_chunk(const LAS float* buf, int lt, float (&s)[4], float (&n)[4]) {
  const int rw = lt >> 4, kq = lt & 15; float myo = 0.f;
  const LAS float* vb = buf + kq * 4;
  StepV<NV> A, B; ld_step<NV, SC>(A, vb, buf, 0, rw);
#pragma unroll 1
  for (int t = 0; t < 16; t += 2) {
    ld_step<NV, SC>(B, vb, buf, t + 1, rw); scan_step<MIX, NV>(A, s, n, myo, kq, t);
    ld_step<NV, SC>(A, vb, buf, t + 2, rw); scan_step<MIX, NV>(B, s, n, myo, kq, t + 1);
  }
  return myo;
}
__device__ __forceinline__ float scan_compute(const LAS float* buf, int mixer, int lt, float (&s)[4], float (&n)[4]) {
  if (mixer == 0) return scan_chunk<0, 3, false>(buf, lt, s, n);
  if (mixer == 1) return scan_chunk<1, 5, false>(buf, lt, s, n);
  if (mixer == 2) return scan_chunk<2, 2, true>(buf, lt, s, n);
  return scan_chunk<3, 2, true>(buf, lt, s, n);
}

__device__ __forceinline__ void phase_scan(const KP& p, int layer, LAS float* lds) {
  const int tid = otid(), half = tid >> 8, lt = tid & 255;
  const int odd = layer & 1;
  LAS float* hb = lds + half * (2 * 5632);
  bf16_t* O = (bf16_t*)(p.ws + OFF_O);
  for (int pair = blockIdx.x; pair < 256; pair += gridDim.x) {
    const int item = half * 256 + pair, sub = item & 127;
#ifdef FORCE_MIXER
    const int mixer = FORCE_MIXER;
#else
    const int mixer = __builtin_amdgcn_readfirstlane(item >> 7);
#endif
    const int d = sub >> 6, b = (sub >> 4) & 3, h = (sub >> 2) & 3, rq = sub & 3;
    const int cm = (mixer < 2) ? odd : !odd;
    float ka[4] = {0.f, 0.f, 0.f, 0.f}, ib = 0.f, fb = 0.f;
    if (mixer == 1) { const float* k_a = p.in[I_RKA] + layer * 256 + h * 64 + (lt & 15) * 4; ka[0] = k_a[0]; ka[1] = k_a[1]; ka[2] = k_a[2]; ka[3] = k_a[3]; }
    if (mixer == 3) { ib = p.in[I_MIB][layer * 8 + d * 4 + h]; fb = p.in[I_MFB][layer * 8 + d * 4 + h]; }
    float s[4] = {0.f, 0.f, 0.f, 0.f}, n[4] = {0.f, 0.f, 0.f, 0.f};
    ScanRegs RA, RB;
    scan_load(RA, mixer, 0, d, b, h, rq, cm, lt, p); scan_load(RB, mixer, 1, d, b, h, rq, cm, lt, p);
    scan_stage(RA, hb, mixer, lt, ka, ib, fb);
    scan_load(RA, mixer, 2, d, b, h, rq, cm, lt, p);
    __syncthreads();
    bf16_t* Od = O + (size_t)d * NTOK * 1024 + mixer * 256 + h * 64 + rq * 16 + (lt >> 4);
    for (int c = 0; c < NCHUNK; c += 2) {
      scan_stage(RB, hb + 5632, mixer, lt, ka, ib, fb);
      scan_load(RB, mixer, c + 3, d, b, h, rq, cm, lt, p);
      { const float o = scan_compute(hb, mixer, lt, s, n); Od[(size_t)seq_row(c * 16 + (lt & 15), d, b, cm) * 1024] = f2bf(o); }
      __syncthreads();
      scan_stage(RA, hb, mixer, lt, ka, ib, fb);
      scan_load(RA, mixer, c + 4, d, b, h, rq, cm, lt, p);
      { const float o = scan_compute(hb + 5632, mixer, lt, s, n); Od[(size_t)seq_row((c + 1) * 16 + (lt & 15), d, b, cm) * 1024] = f2bf(o); }
      __syncthreads();
    }
  }
}

#ifndef PH_MASK
#define PH_MASK 0xFFFF
#endif
__global__ void __launch_bounds__(512, 2) mega(KP p) {
  extern __shared__ __attribute__((aligned(16))) unsigned char shm[];
  cg::grid_group grid = cg::this_grid();
  LAS unsigned char* lds = (LAS unsigned char*)shm;
  float* ldsf = (float*)shm;
  const int tid = threadIdx.x, gtid = blockIdx.x * 512 + tid, gsz = gridDim.x * 512;
  float* MOD = (float*)(p.ws + OFF_MOD);
  volatile LAS unsigned* bst = (volatile LAS unsigned*)(lds + pg8::STAGE_BYTES);
  if (tid < 2) bst[tid] = 0u;
  __syncthreads();
  const XcdBarrier xb = xcd_barrier_post((unsigned*)(p.ws + OFF_BAR), bst);

  { const f32x4* xs = (const f32x4*)p.in[I_X]; f32x4* xd = (f32x4*)p.out;
    for (int i = gtid; i < NLAT * DM / 4; i += gsz) xd[i] = xs[i];
    const f32x4* cs = (const f32x4*)p.in[I_CTX]; f32x4* cd = (f32x4*)(p.ws + OFF_XC);
    for (int i = gtid; i < 1024 * DM / 4; i += gsz) cd[i] = cs[i];
    for (int i = tid; i < 5 * 1024; i += 512) { const float cv = i < 4096 ? p.in[I_C][i] : p.in[I_CCTX][i - 4096]; ldsf[i] = siluf_(cv); }
    __syncthreads();
    float* MODP = (float*)(p.ws + OFF_MODP);
    for (int g = gtid; g < NLAYER * 8 * 6144; g += gsz) { const int col = g % 6144, ks = (g / 6144) & 7, l = g / (6144 * 8);
      const float* w = p.in[I_ADAW] + ((size_t)l * 1024 + ks * 128) * 6144 + col; float a[5] = {0.f, 0.f, 0.f, 0.f, 0.f};
      for (int k = 0; k < 128; ++k) { const float wv = w[(size_t)k * 6144];
#pragma unroll
        for (int b = 0; b < 5; ++b) a[b] += ldsf[b * 1024 + ks * 128 + k] * wv; }
#pragma unroll
      for (int b = 0; b < 5; ++b) MODP[(((size_t)ks * NLAYER + l) * 5 + b) * 6144 + col] = a[b]; }
    if (gtid < 512) { const int dc = gtid; const float* gm = p.in[I_HGAMMA]; float e[4], mx = -1e30f, sum = 0.f;
      for (int l = 0; l < 4; ++l) mx = fmaxf(mx, gm[l * 512 + dc]);
      for (int l = 0; l < 4; ++l) { e[l] = __expf(gm[l * 512 + dc] - mx); sum += e[l]; }
      float* LB = (float*)(p.ws + OFF_LB); float cum = 0.f; LB[dc] = 0.f;
      for (int l = 1; l < 4; ++l) { cum += e[l] / sum; LB[l * 512 + dc] = cum; } }
    __syncthreads();
    phase_convert_weights(p, 0, ldsf);
  }
  grid.sync();
  { const float* MODP = (const float*)(p.ws + OFF_MODP);
    for (int i = gtid; i < NLAYER * 5 * 6144; i += gsz) { const int col = i % 6144, l = i / (5 * 6144); float a = p.in[I_ADAB][l * 6144 + col];
#pragma unroll
      for (int ks = 0; ks < 8; ++ks) a += MODP[(size_t)ks * NLAYER * 5 * 6144 + i];
      MOD[i] = a; } }
  xcd_barrier(xb);
  phase_modulate(p, 0);
  xcd_barrier(xb);

  for (int layer = 0; layer < NLAYER; ++layer) {
    const bool lastl = (layer == NLAYER - 1);
    const float* modl = MOD + (size_t)layer * 5 * 6144;
    pg8::StaticOrder S;
    if (PH_MASK & 1) { pg8::Gemm g{(const bf16_t*)(p.ws + OFF_HA), (const bf16_t*)(p.ws + OFF_WIN), NTOK, LDP, 1024};
      pg8::EpiB E{(bf16_t*)(p.ws + OFF_P), LDP, 0, (const float*)(p.ws + OFF_LB) + layer * 512, nullptr};
      S.init(g.M, g.N, gridDim.x, blockIdx.x); pg8::gemm_phase(lds, g, S, E); }
    xcd_barrier(xb);
    if (PH_MASK & 2) phase_prep(p, layer);
    xcd_barrier(xb);
    if (PH_MASK & 4) { pg8::Gemm g{(const bf16_t*)(p.ws + OFF_U), (const bf16_t*)(p.ws + OFF_WC), NTOK, 1280, 384};
      pg8::EpiB E{(bf16_t*)(p.ws + OFF_RP), 2304, 2, p.in[I_RW0] + layer * 512, p.in[I_RA0] + layer * 512};
      S.init(g.M, g.N, gridDim.x, blockIdx.x); pg8::gemm_phase(lds, g, S, E); }
    xcd_barrier(xb);
    if (PH_MASK & 8) phase_scan(p, layer, (LAS float*)lds);
    xcd_barrier(xb);
    const int nrows = lastl ? NLAT : NTOK;
    if (PH_MASK & 16) phase_finish(p, layer, nrows);
    xcd_barrier(xb);
    if (PH_MASK & 32) { pg8::Gemm g{(const bf16_t*)(p.ws + OFF_YMIX), (const bf16_t*)(p.ws + OFF_WOUT), nrows, 1024, 1024};
      pg8::EpiR E{p.out, (float*)(p.ws + OFF_XC), modl + 2 * 1024};
      S.init(g.M, g.N, gridDim.x, blockIdx.x); pg8::gemm_phase(lds, g, S, E); }
    xcd_barrier(xb);
    phase_ln(p, p.in[I_LN1G] + layer * 1024, p.in[I_LN1B] + layer * 1024, modl, 3 * 1024, nrows);
    xcd_barrier(xb);
    if (PH_MASK & 64) { pg8::Gemm g{(const bf16_t*)(p.ws + OFF_HA), (const bf16_t*)(p.ws + OFF_W1), nrows, DFF, 1024};
      pg8::EpiB E{(bf16_t*)(p.ws + OFF_HID), DFF, 1, nullptr, nullptr};
      S.init(g.M, g.N, gridDim.x, blockIdx.x); pg8::gemm_phase(lds, g, S, E); }
    xcd_barrier(xb);
    if (PH_MASK & 128) { pg8::Gemm g{(const bf16_t*)(p.ws + OFF_HID), (const bf16_t*)(p.ws + OFF_W2), nrows, 1024, DFF};
      pg8::EpiR E{p.out, (float*)(p.ws + OFF_XC), modl + 5 * 1024};
      S.init(g.M, g.N, gridDim.x, blockIdx.x); pg8::gemm_phase(lds, g, S, E); }
    xcd_barrier(xb);
    phase_ln(p, p.in[I_LN2G] + layer * 1024, p.in[I_LN2B] + layer * 1024, lastl ? nullptr : modl + 5 * 6144, 0, nrows);
    if (!lastl) { __syncthreads(); phase_convert_weights(p, layer + 1, ldsf); xcd_barrier(xb); }
  }
}

extern "C" void kernel_launch(void* const* d_in, const int* in_sizes, int n_in, void* d_out, int out_size, void* d_ws, size_t ws_size, hipStream_t stream) {
  constexpr size_t kLds = pg8::STAGE_BYTES + 16;
  static int grid = 0;
  if (!grid) {
    int dev = 0, cus = 0, per_cu = 0;
    hipGetDevice(&dev);
    hipDeviceGetAttribute(&cus, hipDeviceAttributeMultiprocessorCount, dev);
    hipFuncSetAttribute((const void*)mega, hipFuncAttributeMaxDynamicSharedMemorySize, (int)kLds);
    hipOccupancyMaxActiveBlocksPerMultiprocessor(&per_cu, (const void*)mega, 512, kLds);
    if (per_cu < 1) per_cu = 1;
    grid = cus * per_cu;
    if (grid > 256) grid = 256;
    if (ws_size < WS_END2 || n_in != 34) { fprintf(stderr, "kernel_launch: workspace %zu < %zu or n_in %d != 34\n", ws_size, (size_t)WS_END2, n_in); grid = -1; }
  }
  if (grid < 0) return;
  hipMemsetAsync((unsigned char*)d_ws + OFF_BAR, 0, (size_t)XCD_BAR_WORDS * 4, stream);
  KP p{};
  for (int i = 0; i < 34; ++i) p.in[i] = (const float*)d_in[i];
  p.out = (float*)d_out; p.ws = (unsigned char*)d_ws;
  void* args[] = {&p};
  hipError_t e = hipLaunchCooperativeKernel((const void*)mega, dim3(grid), dim3(512), args, kLds, stream);
  if (e != hipSuccess) fprintf(stderr, "cooperative launch failed: %s (grid %d)\n", hipGetErrorString(e), grid);
}
```

```cpp
#include <hip/hip_runtime.h>
#include <hip/hip_cooperative_groups.h>
#include <cstdio>
namespace cg = cooperative_groups;

#define LAS __attribute__((address_space(3)))
typedef unsigned short bf16_t;
typedef short bf16x8 __attribute__((ext_vector_type(8)));
typedef float f32x4 __attribute__((ext_vector_type(4)));
typedef unsigned u32x4 __attribute__((ext_vector_type(4)));
typedef unsigned u32x2 __attribute__((ext_vector_type(2)));

constexpr int NTOK = 17408, NLAT = 16384, DM = 1024, LDP = 4608, DIN = 4512, DFF = 4096, NLAYER = 4;
constexpr int NCHUNK = 272, XCD_BAR_WORDS_C = 3456;
constexpr float ALPHA = 1.681792830507429f;
enum { I_X = 0, I_C, I_CTX, I_CCTX, I_ADAW, I_ADAB, I_WIN, I_WOUT, I_LN1G, I_LN1B, I_LN2G, I_LN2B, I_W1, I_W2, I_HGAMMA, I_HNORM,
       I_RMU, I_RW0, I_RW2, I_RA0, I_RA2, I_RG2, I_RKK, I_RKA, I_RRK, I_RLNG, I_RLNB, I_GCONV, I_GALOG, I_GDT, I_GNORM, I_MIB, I_MFB, I_MNORM };
constexpr size_t al256(size_t x) { return (x + 255) & ~(size_t)255; }
constexpr size_t OFF_XC = 0;
constexpr size_t OFF_MOD = OFF_XC + (size_t)1024 * 1024 * 4;
constexpr size_t OFF_LB = OFF_MOD + al256((size_t)NLAYER * 5 * 6144 * 4);
constexpr size_t OFF_GS = OFF_LB + al256((size_t)NLAYER * 2 * 256 * 4);
constexpr size_t OFF_WIN = OFF_GS + al256((size_t)NTOK * 16 * 4);
constexpr size_t OFF_WOUT = OFF_WIN + (size_t)LDP * 1024 * 2;
constexpr size_t OFF_W1 = OFF_WOUT + (size_t)1024 * 1024 * 2;
constexpr size_t OFF_W2 = OFF_W1 + (size_t)4096 * 1024 * 2;
constexpr size_t OFF_WC = OFF_W2 + (size_t)4096 * 1024 * 2;
constexpr size_t OFF_P = OFF_WC + al256((size_t)1280 * 384 * 2);
constexpr size_t OFF_O = OFF_P + (size_t)NTOK * LDP * 2;
constexpr size_t OFF_RP = OFF_O + (size_t)2 * NTOK * 1024 * 2;
constexpr size_t OFF_GP = OFF_RP + (size_t)NTOK * 2304 * 2;
constexpr size_t WS_END = OFF_GP + (size_t)NTOK * 768 * 2;
constexpr size_t OFF_BAR = WS_END, OFF_YC = al256(OFF_BAR + (size_t)XCD_BAR_WORDS_C * 4), WS_END2 = OFF_YC + (size_t)4 * 1024 * 1024 * 4;
constexpr size_t OFF_YMIX = OFF_O, OFF_U = OFF_O, OFF_MODP = OFF_O, OFF_HA = OFF_O + (size_t)NTOK * 1024 * 2, OFF_HID = OFF_P;

struct KP { const float* in[34]; float* out; unsigned char* ws; };

__device__ __forceinline__ float bf2f(unsigned short b) { return __uint_as_float(((unsigned)b) << 16); }
__device__ __forceinline__ float bflo(unsigned u) { return __uint_as_float(u << 16); }
__device__ __forceinline__ float bfhi(unsigned u) { return __uint_as_float(u & 0xffff0000u); }
__device__ __forceinline__ unsigned cvt_pk_bf16(float lo, float hi) { unsigned r; asm volatile("v_cvt_pk_bf16_f32 %0, %1, %2" : "=v"(r) : "v"(lo), "v"(hi)); return r; }
__device__ __forceinline__ unsigned short f2bf(float f) { return (unsigned short)(cvt_pk_bf16(f, 0.f) & 0xffffu); }
template <int CTRL> __device__ __forceinline__ float dppf(float x) { return __builtin_bit_cast(float, __builtin_amdgcn_mov_dpp(__builtin_bit_cast(int, x), CTRL, 0xf, 0xf, true)); }
__device__ __forceinline__ float allred16(float x) { x += dppf<0x128>(x); x += dppf<0x124>(x); x += dppf<0x4E>(x); x += dppf<0xB1>(x); return x; }
__device__ __forceinline__ float allred64(float x) { x = allred16(x); x += __shfl_xor(x, 16); x += __shfl_xor(x, 32); return x; }
__device__ __forceinline__ float sigmoidf_(float x) { return 1.0f / (1.0f + __expf(-x)); }
__device__ __forceinline__ float siluf_(float x) { return x / (1.0f + __expf(-x)); }
__device__ __forceinline__ float softplusf_(float x) { return fmaxf(x, 0.f) + __logf(1.0f + __expf(-fabsf(x))); }
__device__ __forceinline__ int otid() { int t = threadIdx.x; asm volatile("" : "+v"(t)); return t; }
__device__ __forceinline__ float* xrow(const KP& p, int row) { return row < NLAT ? p.out + (size_t)row * DM : (float*)(p.ws + OFF_XC) + (size_t)(row - NLAT) * DM; }
__device__ __forceinline__ int cmperm(int n) { return ((n & 63) << 6) | (n >> 6); }
__device__ __forceinline__ int seq_row(int s, int d, int b, int cm) {
  if (s < 256) { const int p = d ? 255 - s : s; return NLAT + b * 256 + p; }
  const int q = s - 256, p = d ? 4095 - q : q; return b * 4096 + (cm ? cmperm(p) : p);
}
__device__ __forceinline__ int nbr_row(int r, int cm, int dp) {
  if (r >= NLAT) { const int q = r - NLAT, b = q >> 8, p = (q & 255) + dp; return (p < 0 || p > 255) ? -1 : NLAT + b * 256 + p; }
  const int b = r >> 12, n = r & 4095; int p = (cm ? cmperm(n) : n) + dp; if (p < 0 || p > 4095) return -1;
  return b * 4096 + (cm ? cmperm(p) : p);
}
__device__ __forceinline__ void unpack4(u32x2 u, float (&f)[4]) { f[0] = bflo(u.x); f[1] = bfhi(u.x); f[2] = bflo(u.y); f[3] = bfhi(u.y); }
__device__ __forceinline__ u32x2 pack4(const float (&f)[4]) { u32x2 u; u.x = cvt_pk_bf16(f[0], f[1]); u.y = cvt_pk_bf16(f[2], f[3]); return u; }


#define XB_TMO      128
#define XB_XCNT(j)  (256  + 64 * (j))
#define XB_XSUB(j)  (1280 + 64 * (j))
#define XB_XGEN(j)  (2304 + 64 * (j))
#define XB_TOP      3328
#define XB_TOPGEN   3392
#define XCD_BAR_WORDS 3456
#define XB_SPIN_CAP (1u << 18)
__device__ __forceinline__ unsigned xb_ld(unsigned* p)              { return __hip_atomic_load(p, __ATOMIC_RELAXED, __HIP_MEMORY_SCOPE_AGENT); }
__device__ __forceinline__ unsigned xb_add(unsigned* p, unsigned v) { return __hip_atomic_fetch_add(p, v, __ATOMIC_RELAXED, __HIP_MEMORY_SCOPE_AGENT); }
__device__ __forceinline__ unsigned xb_xcc_id() { return (unsigned)__builtin_amdgcn_s_getreg((3 << 11) | 20) & 0xFu; }
#define XB_SPIN(cond, bar) do { unsigned _sp = 0; while (cond) { __builtin_amdgcn_s_sleep(1); \
    if ((++_sp & 255u) == 0u) { if (xb_ld(&(bar)[XB_TMO])) break; if (_sp > XB_SPIN_CAP) { atomicAdd(&(bar)[XB_TMO], 1u); break; } } } } while (0)
struct XcdBarrier { unsigned* bar; unsigned x; volatile LAS unsigned* st; };
__device__ __forceinline__ XcdBarrier xcd_barrier_post(unsigned* bar, volatile LAS unsigned* st) {
    XcdBarrier b; b.bar = bar; b.x = xb_xcc_id(); b.st = st;
    if (threadIdx.x == 0) (void)xb_add(&bar[XB_XCNT(b.x)], 1u);
    return b;
}
__device__ __forceinline__ void xcd_barrier_complete(unsigned* bar, unsigned x, unsigned& nloc, unsigned& nx) {
    const unsigned G = gridDim.x * gridDim.y * gridDim.z;
    unsigned sum, cnt, mine, sp = 0u;
    for (;;) {
        sum = 0u; cnt = 0u; mine = 0u;
#pragma unroll
        for (unsigned j = 0; j < 16; ++j) { const unsigned c = xb_ld(&bar[XB_XCNT(j)]); sum += c; cnt += (c > 0u) ? 1u : 0u; mine = (j == x) ? c : mine; }
        if (sum == G) break;
        __builtin_amdgcn_s_sleep(1);
        if ((++sp & 255u) == 0u) { if (xb_ld(&bar[XB_TMO])) break; if (sp > XB_SPIN_CAP) { atomicAdd(&bar[XB_TMO], 1u); break; } }
    }
    nloc = mine > 0u ? mine : 1u; nx = cnt > 0u ? cnt : 1u;
}
__device__ __forceinline__ void xcd_barrier(const XcdBarrier& b) {
    asm volatile("s_waitcnt vmcnt(0)" ::: "memory");
    __syncthreads();
    if (threadIdx.x == 0) {
        unsigned* bar = b.bar;
        __builtin_amdgcn_s_waitcnt(0);
        unsigned nloc = b.st[0], nx = b.st[1];
        if (nloc == 0u) { xcd_barrier_complete(bar, b.x, nloc, nx); b.st[0] = nloc; b.st[1] = nx; }
        const unsigned old = xb_add(&bar[XB_XSUB(b.x)], 1u);
        const unsigned gen = old / nloc;
        if (old + 1u == (gen + 1u) * nloc) {
            __builtin_amdgcn_fence(__ATOMIC_RELEASE, "agent");
            asm volatile("s_waitcnt vmcnt(0)" ::: "memory");
            const unsigned og = xb_add(&bar[XB_TOP], 1u);
            const unsigned tg = og / nx;
            if (og + 1u == (tg + 1u) * nx) xb_add(&bar[XB_TOPGEN], 1u);
            else XB_SPIN(xb_ld(&bar[XB_TOPGEN]) == tg, bar);
            __builtin_amdgcn_fence(__ATOMIC_ACQUIRE, "agent");
            xb_add(&bar[XB_XGEN(b.x)], 1u);
            asm volatile("s_waitcnt vmcnt(0)" ::: "memory");
        } else {
            XB_SPIN(xb_ld(&bar[XB_XGEN(b.x)]) == gen, bar);
            __builtin_amdgcn_fence(__ATOMIC_ACQUIRE, "agent");
            asm volatile("s_waitcnt vmcnt(0)" ::: "memory");
        }
    }
    __syncthreads();
}

namespace pg8 {
constexpr int BM = 256, BK = 64, HALF = 128, HTB = HALF * BK * 2, STAGE_BYTES = 8 * HTB, NXCD = 8, WGM = 8;
__host__ __device__ __forceinline__ int lds_byte(int r, int c) { const int st = (r >> 4) * 2 + (c >> 5), rr = r & 15, cc = c & 31, ob = rr * 64 + cc * 2; return st * 1024 + (ob ^ (((ob >> 9) & 1) << 5)); }
__host__ __device__ __forceinline__ void stage_rc(int b, int& R, int& C) { const int st = b / 1024, sb = b % 1024, swz = sb ^ (((sb >> 9) & 1) << 5); R = (st >> 1) * 16 + swz / 64; C = (st & 1) * 32 + (swz % 64) / 2; }
__host__ __device__ __forceinline__ int perm32(int rho) { const int n = rho >> 4, i = rho & 15; return 8 * (i >> 2) + 4 * n + (i & 3); }
struct Unit { int pm, pn, ks; };
struct Gemm { const bf16_t* A; const bf16_t* Bt; int M, N, K, lda, ldb, S; };
struct StaticOrder {
  int nM, nN, nwg, per, G, c;
  __device__ void init(int M, int N, int S, int G_, int c_) { nM = M / BM; nN = N / BM; per = nM * nN; nwg = per * S; G = G_; c = c_; }
  __device__ bool next(int i, Unit& u) const {
    const long L = (long)i * G + c; if (L >= nwg) return false;
    u.ks = (int)(L / per);
    int wgid = (int)(L % per); { const int q = per / NXCD, r = per % NXCD, xcd = wgid % NXCD, off = wgid / NXCD; wgid = (xcd < r ? xcd * (q + 1) : r * (q + 1) + (xcd - r) * q) + off; }
    const int nig = WGM * nN, gid = wgid / nig, fm = gid * WGM, gsz = (nM - fm) < WGM ? (nM - fm) : WGM;
    u.pm = fm + ((wgid % nig) % gsz); u.pn = (wgid % nig) / gsz; return true;
  }
};

template <class Epi>
__device__ __forceinline__ void gemm_phase(LAS unsigned char* lds, const Gemm g, const StaticOrder& S, const Epi& E) {
  const int tid = otid(), wid = __builtin_amdgcn_readfirstlane(tid >> 6), lane = tid & 63, wr = wid >> 2, wc = wid & 3, fr = lane & 15, fq = lane >> 4;
  int K = g.K; asm volatile("" : "+s"(K));
  const int nt = K / BK;
  unsigned voffA[2], voffB[2];
#pragma unroll
  for (int i = 0; i < 2; ++i) { int R, C; stage_rc(tid * 16 + i * 8192, R, C); const int Rb = Epi::PERM ? ((R & ~31) + perm32(R & 31)) : R;
    voffA[i] = (unsigned)(R * g.lda + C) * 2u; voffB[i] = (unsigned)(Rb * g.ldb + C) * 2u; }
  const size_t kstep = (size_t)(BK * 2);
  const size_t hstepA = (size_t)HALF * g.lda * 2, hstepB = (size_t)HALF * g.ldb * 2;
  const size_t tstepA = 2 * hstepA, tstepB = 2 * hstepB, ksplit = (size_t)K * 2;
  const unsigned ldsw = (unsigned)wid * 1024u;
  const int aoff = lds_byte(wr * 64 + fr, fq * 8), boff = lds_byte(wc * 32 + fr, fq * 8);
#define PG8_SA(b, h) (((b) * 2 + (h)) * HTB)
#define PG8_SB(b, h) ((4 + (b) * 2 + (h)) * HTB)
#define PG8_STAGE(bufoff, gbase, voff) do { _Pragma("unroll") for (int _i = 0; _i < 2; ++_i) \
    __builtin_amdgcn_global_load_lds((const unsigned*)((const char*)(gbase) + (voff)[_i]), (LAS unsigned*)(lds + (bufoff) + ldsw + _i * 8192), 16, 0, 0); } while (0)
#define PG8_LDA(dst, b, h) do { _Pragma("unroll") for (int m = 0; m < 4; ++m) _Pragma("unroll") for (int k = 0; k < 2; ++k) dst[m][k] = *(const LAS bf16x8*)(lds + PG8_SA(b, h) + aoff + m * 2048 + k * 1024); } while (0)
#define PG8_LDB(dst, b, h) do { _Pragma("unroll") for (int n = 0; n < 2; ++n) _Pragma("unroll") for (int k = 0; k < 2; ++k) dst[n][k] = *(const LAS bf16x8*)(lds + PG8_SB(b, h) + boff + n * 2048 + k * 1024); } while (0)
#define PG8_MMA(ai, bj, At, Bt) do { __builtin_amdgcn_s_setprio(1); _Pragma("unroll") for (int m = 0; m < 4; ++m) _Pragma("unroll") for (int n = 0; n < 2; ++n) _Pragma("unroll") for (int k = 0; k < 2; ++k) \
    acc[ai][bj][m][n] = __builtin_amdgcn_mfma_f32_16x16x32_bf16(Bt[n][k], At[m][k], acc[ai][bj][m][n], 0, 0, 0); __builtin_amdgcn_s_setprio(0); } while (0)
#define PG8_WAIT_V(n) asm volatile("s_waitcnt vmcnt(" #n ")" ::: "memory")
#define PG8_WAIT_L(n) asm volatile("s_waitcnt lgkmcnt(" #n ")" ::: "memory")
#define PG8_BAR __builtin_amdgcn_s_barrier()
#define PG8_SCHED __builtin_amdgcn_sched_barrier(0)
  Unit cur, nxt; int ui = 0;
  if (!S.next(0, cur)) return;
  f32x4 acc[2][2][4][2];
#pragma unroll
  for (int a = 0; a < 2; ++a)
#pragma unroll
    for (int b = 0; b < 2; ++b)
#pragma unroll
      for (int m = 0; m < 4; ++m)
#pragma unroll
        for (int n = 0; n < 2; ++n) acc[a][b][m][n] = (f32x4){0.f, 0.f, 0.f, 0.f};
  bf16x8 At[4][2], B0[2][2], B1[2][2];
  const char* cA = (const char*)g.A + (size_t)cur.pm * tstepA + cur.ks * ksplit; const char* cB = (const char*)g.Bt + (size_t)cur.pn * tstepB + cur.ks * ksplit;
  PG8_STAGE(PG8_SB(0, 0), cB, voffB); PG8_STAGE(PG8_SA(0, 0), cA, voffA); PG8_STAGE(PG8_SB(0, 1), cB + hstepB, voffB); PG8_STAGE(PG8_SA(0, 1), cA + hstepA, voffA);
  if (wr == 1) PG8_BAR;
  PG8_WAIT_V(4); PG8_BAR;
  PG8_STAGE(PG8_SB(1, 0), cB + kstep, voffB); PG8_STAGE(PG8_SA(1, 0), cA + kstep, voffA); PG8_STAGE(PG8_SB(1, 1), cB + hstepB + kstep, voffB);
  PG8_WAIT_V(6); PG8_BAR;
  for (;;) {
    const bool has_next = S.next(ui + 1, nxt);
    const char* nA = has_next ? (const char*)g.A + (size_t)nxt.pm * tstepA + nxt.ks * ksplit : cA; const char* nB = has_next ? (const char*)g.Bt + (size_t)nxt.pn * tstepB + nxt.ks * ksplit : cB;
    for (int t = 0; t < nt; t += 2) {
      const bool last = (t == nt - 2);
      const char* a1 = cA + (size_t)(t + 1) * kstep;
      const char* a2 = last ? nA : cA + (size_t)(t + 2) * kstep; const char* b2 = last ? nB : cB + (size_t)(t + 2) * kstep;
      const char* a3 = a2 + kstep; const char* b3 = b2 + kstep;
      PG8_LDB(B0, 0, 0); PG8_SCHED; PG8_LDA(At, 0, 0); PG8_STAGE(PG8_SA(1, 1), a1 + hstepA, voffA);
      PG8_WAIT_L(8); PG8_BAR; PG8_WAIT_L(0); PG8_MMA(0, 0, At, B0); PG8_BAR; PG8_SCHED;
      PG8_LDB(B1, 0, 1); PG8_STAGE(PG8_SB(0, 0), b2, voffB);
      PG8_BAR; PG8_WAIT_L(0); PG8_MMA(0, 1, At, B1); PG8_BAR;
      PG8_LDA(At, 0, 1); PG8_STAGE(PG8_SA(0, 0), a2, voffA);
      PG8_BAR; PG8_WAIT_L(0); PG8_MMA(1, 0, At, B0); PG8_BAR; PG8_SCHED;
      PG8_STAGE(PG8_SB(0, 1), b2 + hstepB, voffB);
      PG8_WAIT_V(6); PG8_BAR; PG8_MMA(1, 1, At, B1); PG8_BAR;
      PG8_LDB(B0, 1, 0); PG8_SCHED; PG8_LDA(At, 1, 0); PG8_STAGE(PG8_SA(0, 1), a2 + hstepA, voffA);
      PG8_WAIT_L(8); PG8_BAR; PG8_WAIT_L(0); PG8_MMA(0, 0, At, B0); PG8_BAR; PG8_SCHED;
      PG8_LDB(B1, 1, 1); PG8_STAGE(PG8_SB(1, 0), b3, voffB);
      PG8_BAR; PG8_WAIT_L(0); PG8_MMA(0, 1, At, B1); PG8_BAR;
      PG8_LDA(At, 1, 1); PG8_STAGE(PG8_SA(1, 0), a3, voffA);
      PG8_BAR; PG8_WAIT_L(0); PG8_MMA(1, 0, At, B0); PG8_BAR; PG8_SCHED;
      PG8_STAGE(PG8_SB(1, 1), b3 + hstepB, voffB);
      PG8_WAIT_V(6); PG8_BAR; PG8_MMA(1, 1, At, B1); PG8_BAR;
    }
    E(acc, cur, wr, wc, fr, fq);
    if (!has_next) break;
#pragma unroll
    for (int a = 0; a < 2; ++a)
#pragma unroll
      for (int b = 0; b < 2; ++b)
#pragma unroll
        for (int m = 0; m < 4; ++m)
#pragma unroll
          for (int n = 0; n < 2; ++n) acc[a][b][m][n] = (f32x4){0.f, 0.f, 0.f, 0.f};
    cur = nxt; cA = nA; cB = nB; ++ui;
  }
  PG8_WAIT_V(0);
  if (wr == 0) PG8_BAR;
  PG8_BAR;
#undef PG8_SA
#undef PG8_SB
#undef PG8_STAGE
#undef PG8_LDA
#undef PG8_LDB
#undef PG8_MMA
#undef PG8_WAIT_V
#undef PG8_WAIT_L
#undef PG8_BAR
#undef PG8_SCHED
}

struct EpiB {
  static constexpr bool PERM = true;
  bf16_t* O; int ldc; int mode; const float* aux0; const float* aux1;
  __device__ __forceinline__ void operator()(const f32x4 (&acc)[2][2][4][2], const Unit& u, int wr, int wc, int fr, int fq) const {
    const int row0 = u.pm * BM + wr * 64 + fr;
    const int cin = wc * 32 + 8 * fq;
    const int col0 = (mode == 2 ? 1024 : 0) + u.pn * BM + cin;
    const bool special = (mode == 0) ? (u.pn == 2 || u.pn == 3) : (mode == 2 ? (u.pn < 4) : false);
    const float* auxp = nullptr;
    if (mode == 0) auxp = aux0 + ((u.pn - 2) & 1) * 256 + cin;
    if (mode == 2) auxp = (u.pn < 2 ? aux0 : aux1) + (u.pn & 1) * 256 + cin;
#pragma unroll
    for (int ai = 0; ai < 2; ++ai)
#pragma unroll
      for (int m = 0; m < 4; ++m) {
        bf16_t* rowp = O + (size_t)(row0 + ai * HALF + m * 16) * ldc + col0;
#pragma unroll
        for (int bj = 0; bj < 2; ++bj) {
          float v[8];
#pragma unroll
          for (int j = 0; j < 4; ++j) { v[j] = acc[ai][bj][m][0][j]; v[4 + j] = acc[ai][bj][m][1][j]; }
          if (mode == 1) {
#pragma unroll
            for (int j = 0; j < 8; ++j) { const float r = fmaxf(v[j], 0.f); v[j] = r * r; }
          } else if (special) {
            const f32x4 x0 = *(const f32x4*)(auxp + bj * HALF), x1 = *(const f32x4*)(auxp + bj * HALF + 4);
            if (mode == 0) {
#pragma unroll
              for (int j = 0; j < 4; ++j) { v[j] = (1.0f - x0[j]) / (1.0f + __expf(v[j])); v[4 + j] = (1.0f - x1[j]) / (1.0f + __expf(v[4 + j])); }
            } else {
#pragma unroll
              for (int j = 0; j < 4; ++j) { v[j] += x0[j]; v[4 + j] += x1[j]; }
            }
          }
          u32x4 w; w.x = cvt_pk_bf16(v[0], v[1]); w.y = cvt_pk_bf16(v[2], v[3]); w.z = cvt_pk_bf16(v[4], v[5]); w.w = cvt_pk_bf16(v[6], v[7]);
          *(u32x4*)(rowp + bj * HALF) = w;
        }
      }
  }
};
struct EpiR {
  static constexpr bool PERM = false;
  float* xlat; float* xctx; const float* gate;
  __device__ __forceinline__ void operator()(const f32x4 (&acc)[2][2][4][2], const Unit& u, int wr, int wc, int fr, int fq) const {
    const int row0 = u.pm * BM + wr * 64 + fr, col0 = u.pn * BM + wc * 32 + 4 * fq;
    const int b5 = (u.pm < 64) ? (u.pm >> 4) : 4;
    f32x4 gv[2][2];
#pragma unroll
    for (int bj = 0; bj < 2; ++bj)
#pragma unroll
      for (int n = 0; n < 2; ++n) gv[bj][n] = *(const f32x4*)(gate + (size_t)b5 * 6144 + col0 + bj * HALF + n * 16);
#pragma unroll
    for (int ai = 0; ai < 2; ++ai)
#pragma unroll
      for (int m = 0; m < 4; ++m) {
        const int row = row0 + ai * HALF + m * 16;
        float* rowp = (row < NLAT ? xlat + (size_t)row * DM : xctx + (size_t)(row - NLAT) * DM) + col0;
#pragma unroll
        for (int bj = 0; bj < 2; ++bj)
#pragma unroll
          for (int n = 0; n < 2; ++n) { f32x4 xv = *(f32x4*)(rowp + bj * HALF + n * 16); xv = xv * ALPHA + gv[bj][n] * acc[ai][bj][m][n]; *(f32x4*)(rowp + bj * HALF + n * 16) = xv; }
      }
  }
};
struct EpiP {
  static constexpr bool PERM = false;
  float* Y; const float* gate;
  __device__ __forceinline__ void operator()(const f32x4 (&acc)[2][2][4][2], const Unit& u, int wr, int wc, int fr, int fq) const {
    const int row0 = u.pm * BM + wr * 64 + fr, col0 = u.pn * BM + wc * 32 + 4 * fq;
    f32x4 gv[2][2];
#pragma unroll
    for (int bj = 0; bj < 2; ++bj)
#pragma unroll
      for (int n = 0; n < 2; ++n) gv[bj][n] = *(const f32x4*)(gate + col0 + bj * HALF + n * 16);
#pragma unroll
    for (int ai = 0; ai < 2; ++ai)
#pragma unroll
      for (int m = 0; m < 4; ++m) {
        float* rowp = Y + ((size_t)u.ks * 1024 + row0 + ai * HALF + m * 16) * DM + col0;
#pragma unroll
        for (int bj = 0; bj < 2; ++bj)
#pragma unroll
          for (int n = 0; n < 2; ++n) *(f32x4*)(rowp + bj * HALF + n * 16) = gv[bj][n] * acc[ai][bj][m][n];
      }
  }
};
}

__device__ __forceinline__ void phase_convert_weights(const KP& p, int layer, float* tile  ) {
  const int tid = otid();
  bf16_t* dWIN = (bf16_t*)(p.ws + OFF_WIN); bf16_t* dWOUT = (bf16_t*)(p.ws + OFF_WOUT); bf16_t* dW1 = (bf16_t*)(p.ws + OFF_W1); bf16_t* dW2 = (bf16_t*)(p.ws + OFF_W2);
  for (int T = blockIdx.x; T < 3456; T += gridDim.x) {
    const float* src; bf16_t* dst; int K, N, t;
    if (T < 1152) { t = T; src = p.in[I_WIN] + (size_t)layer * 1024 * DIN; dst = dWIN; K = 1024; N = DIN; }
    else if (T < 1408) { t = T - 1152; src = p.in[I_WOUT] + (size_t)layer * 1024 * 1024; dst = dWOUT; K = 1024; N = 1024; }
    else if (T < 2432) { t = T - 1408; src = p.in[I_W1] + (size_t)layer * 1024 * DFF; dst = dW1; K = 1024; N = DFF; }
    else { t = T - 2432; src = p.in[I_W2] + (size_t)layer * DFF * 1024; dst = dW2; K = DFF; N = 1024; }
    const int nk = K / 64, tk = t % nk, tn = t / nk;
    { const int j = tid & 63, i0 = tid >> 6;
#pragma unroll
      for (int ii = 0; ii < 8; ++ii) { const int i = i0 + ii * 8; const int n = tn * 64 + j; tile[i * 65 + j] = (n < N) ? src[(size_t)(tk * 64 + i) * N + n] : 0.f; } }
    __syncthreads();
    { const int i2 = (tid & 31) * 2, j0 = tid >> 5;
#pragma unroll
      for (int jj = 0; jj < 4; ++jj) { const int j = j0 + jj * 16; *(unsigned*)(dst + (size_t)(tn * 64 + j) * K + tk * 64 + i2) = cvt_pk_bf16(tile[i2 * 65 + j], tile[(i2 + 1) * 65 + j]); } }
    __syncthreads();
  }
  bf16_t* dWC = (bf16_t*)(p.ws + OFF_WC);
  const float* w2 = p.in[I_RW2] + (size_t)layer * 2 * 64 * 256; const float* a2 = p.in[I_RA2] + (size_t)layer * 2 * 64 * 256; const float* g2 = p.in[I_RG2] + (size_t)layer * 128 * 256;
  for (int idx = blockIdx.x * 512 + tid; idx < 1280 * 384; idx += gridDim.x * 512) {
    const int n = idx / 384, kk = idx % 384, seg = n >> 8, c = n & 255; float v = 0.f;
    if (seg < 2) { if ((kk >> 6) == seg) v = w2[((size_t)seg * 64 + (kk & 63)) * 256 + c]; }
    else if (seg < 4) { if ((kk >> 6) == seg) v = a2[((size_t)(seg - 2) * 64 + (kk & 63)) * 256 + c]; }
    else { if (kk >= 256) v = g2[(size_t)(kk - 256) * 256 + c]; }
    dWC[idx] = f2bf(v);
  }
}

__device__ __forceinline__ void phase_modulate(const KP& p, int layer) {
  const int tid_ = otid(), lane = tid_ & 63, wave = tid_ >> 6;
  const float* mod = (const float*)(p.ws + OFF_MOD) + (size_t)layer * 5 * 6144;
  bf16_t* HA = (bf16_t*)(p.ws + OFF_HA);
  for (int row = blockIdx.x * 8 + wave; row < NTOK; row += gridDim.x * 8) {
    const float* xr = xrow(p, row); const int b5 = row < NLAT ? row >> 12 : 4; const float* mb = mod + (size_t)b5 * 6144;
#pragma unroll
    for (int q = 0; q < 4; ++q) { const int c = q * 256 + lane * 4; const f32x4 xv = *(const f32x4*)(xr + c), sh = *(const f32x4*)(mb + c), sc = *(const f32x4*)(mb + 1024 + c);
      float y[4];
#pragma unroll
      for (int j = 0; j < 4; ++j) y[j] = xv[j] * (1.0f + sc[j]) + sh[j];
      *(u32x2*)(HA + (size_t)row * DM + c) = pack4(y); }
  }
}

__device__ __forceinline__ void phase_ln(const KP& p, const float* g, const float* bta, const float* mod_next, int sh_off, int nrows) {
  const float* YC = (const float*)(p.ws + OFF_YC);
  const int tid_ = otid(), lane = tid_ & 63, wave = tid_ >> 6;
  bf16_t* HA = (bf16_t*)(p.ws + OFF_HA);
  for (int row = blockIdx.x * 8 + wave; row < nrows; row += gridDim.x * 8) {
    float* xr = xrow(p, row); const int b5 = row < NLAT ? row >> 12 : 4;
    f32x4 v[4]; float s = 0.f;
#pragma unroll
    for (int q = 0; q < 4; ++q) { v[q] = *(const f32x4*)(xr + q * 256 + lane * 4);
      if (row >= NLAT) { const float* yp = YC + (size_t)(row - NLAT) * DM + q * 256 + lane * 4;
        v[q] = v[q] * ALPHA + ((*(const f32x4*)yp + *(const f32x4*)(yp + 1024 * 1024)) + (*(const f32x4*)(yp + 2 * 1024 * 1024) + *(const f32x4*)(yp + 3 * 1024 * 1024))); }
      s += v[q][0] + v[q][1] + v[q][2] + v[q][3]; }
    const float mu = allred64(s) * (1.0f / 1024.0f);
    float s2 = 0.f;
#pragma unroll
    for (int q = 0; q < 4; ++q)
#pragma unroll
      for (int j = 0; j < 4; ++j) { v[q][j] -= mu; s2 += v[q][j] * v[q][j]; }
    const float rstd = rsqrtf(allred64(s2) * (1.0f / 1024.0f) + 1e-5f);
#pragma unroll
    for (int q = 0; q < 4; ++q) { const int c = q * 256 + lane * 4; const f32x4 gg = *(const f32x4*)(g + c), bb = *(const f32x4*)(bta + c);
      f32x4 y;
#pragma unroll
      for (int j = 0; j < 4; ++j) y[j] = v[q][j] * rstd * gg[j] + bb[j];
      *(f32x4*)(xr + c) = y;
      if (mod_next) { const float* mb = mod_next + (size_t)b5 * 6144 + sh_off; const f32x4 sh = *(const f32x4*)(mb + c), sc = *(const f32x4*)(mb + 1024 + c);
        float h[4];
#pragma unroll
        for (int j = 0; j < 4; ++j) h[j] = y[j] * (1.0f + sc[j]) + sh[j];
        *(u32x2*)(HA + (size_t)row * DM + c) = pack4(h); } }
  }
}

__device__ __forceinline__ void phase_prep(const KP& p, int layer) {
  const int tid_ = otid(), lane = tid_ & 63, wave = tid_ >> 6;
  const int odd = layer & 1, cmB = odd, cmC = !odd;
  const bf16_t* P = (const bf16_t*)(p.ws + OFF_P); bf16_t* RP = (bf16_t*)(p.ws + OFF_RP); bf16_t* GP = (bf16_t*)(p.ws + OFF_GP); bf16_t* U = (bf16_t*)(p.ws + OFF_U);
  float* GS = (float*)(p.ws + OFF_GS);
  const float* mu = p.in[I_RMU] + (size_t)layer * 1152; const float* k_k = p.in[I_RKK] + (size_t)layer * 256;
  const float* conv = p.in[I_GCONV] + (size_t)layer * 5 * 768;
  for (int row = blockIdx.x * 8 + wave; row < NTOK; row += gridDim.x * 8) {
    { const int rm = nbr_row(row, cmB, -1), rp = nbr_row(row, cmB, +1);
      const bf16_t* b0 = P + (size_t)row * LDP + 1280; const bf16_t* bm = rm >= 0 ? P + (size_t)rm * LDP + 1280 : nullptr; const bf16_t* bp = rp >= 0 ? P + (size_t)rp * LDP + 1280 : nullptr;
#pragma unroll
      for (int seg = 0; seg < 3; ++seg) { const int c = seg * 256 + lane * 4; float x0[4], xm[4] = {0.f, 0.f, 0.f, 0.f}, xp[4] = {0.f, 0.f, 0.f, 0.f}, y[4];
        unpack4(*(const u32x2*)(b0 + c), x0); if (bm) unpack4(*(const u32x2*)(bm + c), xm); if (bp) unpack4(*(const u32x2*)(bp + c), xp);
        const f32x4 m4 = *(const f32x4*)(mu + c);
#pragma unroll
        for (int j = 0; j < 4; ++j) y[j] = x0[j] + m4[j] * (0.5f * (xm[j] + xp[j]) - x0[j]);
        *(u32x2*)(RP + (size_t)row * 2304 + c) = pack4(y);
        if (seg == 1) { const f32x4 kk4 = *(const f32x4*)(k_k + lane * 4); float t[4], ss = 0.f;
#pragma unroll
          for (int j = 0; j < 4; ++j) { t[j] = y[j] * kk4[j]; ss += t[j] * t[j]; }
          const float rn = rsqrtf(allred16(ss) + 1e-12f);
#pragma unroll
          for (int j = 0; j < 4; ++j) t[j] *= rn;
          *(u32x2*)(RP + (size_t)row * 2304 + 768 + lane * 4) = pack4(t); } }
#pragma unroll
      for (int seg = 0; seg < 3; ++seg) { const int c = 768 + seg * 128 + lane * 2;
        const unsigned u0 = *(const unsigned*)(b0 + c), um = bm ? *(const unsigned*)(bm + c) : 0u, up = bp ? *(const unsigned*)(bp + c) : 0u;
        float y0 = bflo(u0), y1 = bfhi(u0);
        y0 = y0 + mu[c] * (0.5f * (bflo(um) + bflo(up)) - y0); y1 = y1 + mu[c + 1] * (0.5f * (bfhi(um) + bfhi(up)) - y1);
        if (seg == 0) { y0 = tanhf(y0); y1 = tanhf(y1); } else if (seg == 2) { y0 = sigmoidf_(y0); y1 = sigmoidf_(y1); }
        *(unsigned*)(U + (size_t)row * 384 + seg * 128 + lane * 2) = cvt_pk_bf16(y0, y1); } }
    { const bf16_t* br[5];
#pragma unroll
      for (int j = 0; j < 5; ++j) { const int rj = (j == 2) ? row : nbr_row(row, cmC, j - 2); br[j] = rj >= 0 ? P + (size_t)rj * LDP + 2432 : nullptr; }
#pragma unroll
      for (int seg = 0; seg < 3; ++seg) { const int c = seg * 256 + lane * 4; float a[4] = {0.f, 0.f, 0.f, 0.f};
#pragma unroll
        for (int j = 0; j < 5; ++j) if (br[j]) { float xv[4]; unpack4(*(const u32x2*)(br[j] + c), xv); const f32x4 w4 = *(const f32x4*)(conv + j * 768 + c);
#pragma unroll
          for (int e = 0; e < 4; ++e) a[e] += xv[e] * w4[e]; }
        float ss = 0.f;
#pragma unroll
        for (int e = 0; e < 4; ++e) { a[e] = siluf_(a[e]); ss += a[e] * a[e]; }
        if (seg < 2) { const float rn = rsqrtf(allred16(ss) + 1e-12f) * (seg == 0 ? 0.125f : 1.0f);
#pragma unroll
          for (int e = 0; e < 4; ++e) a[e] *= rn; }
        *(u32x2*)(GP + (size_t)row * 768 + c) = pack4(a); }
      if (lane < 16) { const int dh = lane & 7; float val;
        if (lane < 8) val = sigmoidf_(bf2f(P[(size_t)row * LDP + 3200 + dh]));
        else { const float la = -__expf(p.in[I_GALOG][layer * 8 + dh]) * softplusf_(bf2f(P[(size_t)row * LDP + 3208 + dh]) + p.in[I_GDT][layer * 8 + dh]); val = __expf(la); }
        GS[(size_t)row * 16 + lane] = val; } }
  }
}

__device__ __forceinline__ void phase_finish(const KP& p, int layer, int nrows) {
  const int tid_ = otid(), lane = tid_ & 63, wave = tid_ >> 6;
  const bf16_t* P = (const bf16_t*)(p.ws + OFF_P); const bf16_t* RP = (const bf16_t*)(p.ws + OFF_RP);
  bf16_t* O0 = (bf16_t*)(p.ws + OFF_O); const bf16_t* O1 = O0 + (size_t)NTOK * 1024;
  const float* hn = p.in[I_HNORM] + layer * 256; const float* gn = p.in[I_GNORM] + layer * 256; const float* mn = p.in[I_MNORM] + layer * 256;
  const float* lng = p.in[I_RLNG] + layer * 256; const float* lnb = p.in[I_RLNB] + layer * 256; const float* k_a = p.in[I_RKA] + layer * 256; const float* r_k = p.in[I_RRK] + layer * 256;
  const int c = lane * 4;
  for (int row = blockIdx.x * 8 + wave; row < nrows; row += gridDim.x * 8) {
    float o[4][4];
#pragma unroll
    for (int g = 0; g < 4; ++g) { float a[4], b[4]; unpack4(*(const u32x2*)(O0 + (size_t)row * 1024 + g * 256 + c), a); unpack4(*(const u32x2*)(O1 + (size_t)row * 1024 + g * 256 + c), b);
#pragma unroll
      for (int j = 0; j < 4; ++j) o[g][j] = a[j] + b[j]; }
    const bf16_t* pr = P + (size_t)row * LDP; const bf16_t* rr = RP + (size_t)row * 2304;
#pragma unroll
    for (int g = 0; g < 4; ++g) { if (g == 1) continue;
      float ss = 0.f;
#pragma unroll
      for (int j = 0; j < 4; ++j) ss += o[g][j] * o[g][j];
      const float rn = rsqrtf(allred16(ss) * (1.0f / 64.0f) + 1e-6f);
      const float* ng = g == 0 ? hn : (g == 2 ? gn : mn); const int gcol = g == 0 ? 1024 : (g == 2 ? 3216 : 4256);
      float gt[4]; unpack4(*(const u32x2*)(pr + gcol + c), gt); const f32x4 n4 = *(const f32x4*)(ng + c);
      float y[4];
#pragma unroll
      for (int j = 0; j < 4; ++j) y[j] = o[g][j] * rn * n4[j] * (g == 3 ? sigmoidf_(gt[j]) : siluf_(gt[j]));
      *(u32x2*)(O0 + (size_t)row * 1024 + g * 256 + c) = pack4(y); }
    { float s = o[1][0] + o[1][1] + o[1][2] + o[1][3];
      const float mu = allred16(s) * (1.0f / 64.0f); float s2 = 0.f;
#pragma unroll
      for (int j = 0; j < 4; ++j) { o[1][j] -= mu; s2 += o[1][j] * o[1][j]; }
      const float rstd = rsqrtf(allred16(s2) * (1.0f / 64.0f) + 64e-5f);
      float r4[4], k4[4], v4[4], af[4], ab[4], gt[4];
      unpack4(*(const u32x2*)(rr + c), r4); unpack4(*(const u32x2*)(rr + 256 + c), k4); unpack4(*(const u32x2*)(rr + 512 + c), v4);
      unpack4(*(const u32x2*)(rr + 1536 + c), af); unpack4(*(const u32x2*)(rr + 1792 + c), ab); unpack4(*(const u32x2*)(rr + 2048 + c), gt);
      const f32x4 ka4 = *(const f32x4*)(k_a + c), rk4 = *(const f32x4*)(r_k + c), g4 = *(const f32x4*)(lng + c), b4 = *(const f32x4*)(lnb + c);
      float bs = 0.f;
#pragma unroll
      for (int j = 0; j < 4; ++j) { const float a0 = sigmoidf_(af[j]), a1 = sigmoidf_(ab[j]); bs += r4[j] * k4[j] * rk4[j] * ((1.0f + (a0 - 1.0f) * ka4[j]) + (1.0f + (a1 - 1.0f) * ka4[j])); }
      bs = allred16(bs);
      float y[4];
#pragma unroll
      for (int j = 0; j < 4; ++j) y[j] = (o[1][j] * rstd * g4[j] + b4[j] + bs * v4[j]) * gt[j];
      *(u32x2*)(O0 + (size_t)row * 1024 + 256 + c) = pack4(y); }
  }
}

constexpr int SBUF = 5696;
struct ScanRegs { u32x2 r[5]; unsigned rv; unsigned short s0, s1; };

__device__ __forceinline__ void scan_load(ScanRegs& R, int mixer, int chunk, int d, int b, int h, int rh, int cm, int lt, const KP& p) {
  if (chunk > NCHUNK - 1) chunk = NCHUNK - 1;
  const int st = lt >> 4, cq = lt & 15;
  const int row = seq_row(chunk * 16 + st, d, b, cm);
  const bf16_t* P = (const bf16_t*)(p.ws + OFF_P);
  if (mixer == 0) { const bf16_t* base = P + (size_t)row * LDP;
    R.r[0] = *(const u32x2*)(base + 512 + d * 256 + h * 64 + cq * 4); R.r[1] = *(const u32x2*)(base + h * 64 + cq * 4); R.rv = *(const unsigned*)(base + 256 + h * 64 + rh * 32 + cq * 2); }
  else if (mixer == 1) { const bf16_t* base = (const bf16_t*)(p.ws + OFF_RP) + (size_t)row * 2304 + h * 64 + cq * 4;
    R.r[0] = *(const u32x2*)(base + 1024 + d * 256); R.r[1] = *(const u32x2*)(base + 1536 + d * 256); R.r[2] = *(const u32x2*)(base + 256); R.r[3] = *(const u32x2*)(base + 768); R.r[4] = *(const u32x2*)(base);
    R.rv = *(const unsigned*)((const bf16_t*)(p.ws + OFF_RP) + (size_t)row * 2304 + 512 + h * 64 + rh * 32 + cq * 2); }
  else if (mixer == 2) { const bf16_t* base = (const bf16_t*)(p.ws + OFF_GP) + (size_t)row * 768;
    R.r[0] = *(const u32x2*)(base + 256 + h * 64 + cq * 4); R.r[1] = *(const u32x2*)(base + h * 64 + cq * 4); R.rv = *(const unsigned*)(base + 512 + h * 64 + rh * 32 + cq * 2);
    if (cq == 0) { const float* gs = (const float*)(p.ws + OFF_GS) + (size_t)row * 16; R.r[2].x = __float_as_uint(gs[8 + d * 4 + h]); R.r[2].y = __float_as_uint(gs[d * 4 + h]); } }
  else { const bf16_t* base = P + (size_t)row * LDP + 3472;
    R.r[0] = *(const u32x2*)(base + 256 + h * 64 + cq * 4); R.r[1] = *(const u32x2*)(base + h * 64 + cq * 4); R.rv = *(const unsigned*)(base + 512 + h * 64 + rh * 32 + cq * 2);
    if (cq == 0) { R.s0 = base[768 + d * 4 + h]; R.s1 = base[776 + d * 4 + h]; } }
}
__device__ __forceinline__ void scan_stage(const ScanRegs& R, LAS float* buf, int mixer, int lt, const float (&ka)[4], float ib, float fb) {
  const int st = lt >> 4, cq = lt & 15; LAS float* v0 = buf + st * 64 + cq * 4;
  float a[4], b[4];
  if (mixer == 0) { unpack4(R.r[0], a); unpack4(R.r[1], b);
    *(LAS f32x4*)(v0) = (f32x4){1.0f - a[0], 1.0f - a[1], 1.0f - a[2], 1.0f - a[3]}; *(LAS f32x4*)(v0 + 1024) = (f32x4){a[0], a[1], a[2], a[3]}; *(LAS f32x4*)(v0 + 2048) = (f32x4){b[0], b[1], b[2], b[3]}; }
  else if (mixer == 1) { float wl[4], aa[4], k[4], kk[4], r[4]; unpack4(R.r[0], wl); unpack4(R.r[1], aa); unpack4(R.r[2], k); unpack4(R.r[3], kk); unpack4(R.r[4], r);
#pragma unroll
    for (int j = 0; j < 4; ++j) { wl[j] = __expf(-__expf(-softplusf_(-wl[j]) - 0.5f)); aa[j] = sigmoidf_(aa[j]); }
    *(LAS f32x4*)(v0) = (f32x4){wl[0], wl[1], wl[2], wl[3]};
    *(LAS f32x4*)(v0 + 1024) = (f32x4){kk[0] * aa[0], kk[1] * aa[1], kk[2] * aa[2], kk[3] * aa[3]};
    *(LAS f32x4*)(v0 + 2048) = (f32x4){k[0] * (1.0f + (aa[0] - 1.0f) * ka[0]), k[1] * (1.0f + (aa[1] - 1.0f) * ka[1]), k[2] * (1.0f + (aa[2] - 1.0f) * ka[2]), k[3] * (1.0f + (aa[3] - 1.0f) * ka[3])};
    *(LAS f32x4*)(v0 + 3072) = (f32x4){kk[0], kk[1], kk[2], kk[3]}; *(LAS f32x4*)(v0 + 4096) = (f32x4){r[0], r[1], r[2], r[3]}; }
  else if (mixer == 2) { unpack4(R.r[0], a); unpack4(R.r[1], b);
    *(LAS f32x4*)(v0) = (f32x4){a[0], a[1], a[2], a[3]}; *(LAS f32x4*)(v0 + 1024) = (f32x4){b[0], b[1], b[2], b[3]};
    if (cq == 0) { buf[5632 + st] = __uint_as_float(R.r[2].x); buf[5648 + st] = __uint_as_float(R.r[2].y); } }
  else { unpack4(R.r[0], a); unpack4(R.r[1], b);
    *(LAS f32x4*)(v0) = (f32x4){a[0] * 0.125f, a[1] * 0.125f, a[2] * 0.125f, a[3] * 0.125f}; *(LAS f32x4*)(v0 + 1024) = (f32x4){b[0], b[1], b[2], b[3]};
    if (cq == 0) { buf[5632 + st] = sigmoidf_(bf2f(R.s1) + fb); buf[5648 + st] = __expf(bf2f(R.s0) + ib); } }
  buf[5120 + st * 32 + cq * 2] = bflo(R.rv); buf[5120 + st * 32 + cq * 2 + 1] = bfhi(R.rv);
}
template <int NV> struct StepV { f32x4 v[NV]; float rv[2], s0, s1; };
template <int NV, bool SC> __device__ __forceinline__ void ld_step(StepV<NV>& S, const LAS float* vb, const LAS float* buf, int t, int r0) {
#pragma unroll
  for (int i = 0; i < NV; ++i) S.v[i] = *(const LAS f32x4*)(vb + i * 1024 + t * 64);
  S.rv[0] = buf[5120 + t * 32 + r0]; S.rv[1] = buf[5120 + t * 32 + r0 + 1];
  if (SC) { S.s0 = buf[5632 + t]; S.s1 = buf[5648 + t]; } else { S.s0 = 0.f; S.s1 = 0.f; }
}
__device__ __forceinline__ float dot4(const f32x4 a, const float (&s)[4]) { return __builtin_fmaf(a[3], s[3], __builtin_fmaf(a[2], s[2], __builtin_fmaf(a[1], s[1], a[0] * s[0]))); }
template <int MIX, int NV> __device__ __forceinline__ void scan_step(const StepV<NV>& c, float (&s)[2][4], float (&n)[2][4], float (&myo)[2], int kq, int t) {
  float o[2];
  if (MIX == 0) {
#pragma unroll
    for (int r = 0; r < 2; ++r) {
#pragma unroll
      for (int i = 0; i < 4; ++i) s[r][i] = __builtin_fmaf(c.v[0][i], s[r][i], c.v[1][i] * c.rv[r]);
      o[r] = dot4(c.v[2], s[r]); }
    o[0] = allred16(o[0]); o[1] = allred16(o[1]);
  } else if (MIX == 1) {
    float sa[2];
#pragma unroll
    for (int r = 0; r < 2; ++r) sa[r] = dot4(c.v[3], s[r]);
    sa[0] = allred16(sa[0]); sa[1] = allred16(sa[1]);
#pragma unroll
    for (int r = 0; r < 2; ++r) {
#pragma unroll
      for (int i = 0; i < 4; ++i) s[r][i] = __builtin_fmaf(s[r][i], c.v[0][i], __builtin_fmaf(-sa[r], c.v[1][i], c.rv[r] * c.v[2][i]));
      o[r] = dot4(c.v[4], s[r]); }
    o[0] = allred16(o[0]); o[1] = allred16(o[1]);
  } else if (MIX == 2) { const float a = c.s0, bt = c.s1;
    float u[2];
#pragma unroll
    for (int r = 0; r < 2; ++r) u[r] = dot4(c.v[0], s[r]);
    u[0] = allred16(u[0]); u[1] = allred16(u[1]);
#pragma unroll
    for (int r = 0; r < 2; ++r) { const float cc = bt * (c.rv[r] - u[r] * a);
#pragma unroll
      for (int i = 0; i < 4; ++i) s[r][i] = __builtin_fmaf(a, s[r][i], cc * c.v[0][i]);
      o[r] = dot4(c.v[1], s[r]); }
    o[0] = allred16(o[0]); o[1] = allred16(o[1]);
  } else { const float f = c.s0, ig = c.s1;
    float den[2];
#pragma unroll
    for (int r = 0; r < 2; ++r) { const float iv = ig * c.rv[r];
#pragma unroll
      for (int i = 0; i < 4; ++i) s[r][i] = __builtin_fmaf(f, s[r][i], iv * c.v[0][i]);
      o[r] = dot4(c.v[1], s[r]); }
#pragma unroll
    for (int i = 0; i < 4; ++i) n[0][i] = __builtin_fmaf(f, n[0][i], ig * c.v[0][i]);
    den[0] = allred16(dot4(c.v[1], n[0]));
    o[0] = allred16(o[0]); o[1] = allred16(o[1]);
    const float rd = __builtin_amdgcn_rcpf(fmaxf(fabsf(den[0]), 1.0f)); o[0] *= rd; o[1] *= rd;
  }
  myo[0] = (kq == t) ? o[0] : myo[0]; myo[1] = (kq == t) ? o[1] : myo[1];
}
template <int MIX, int NV, bool SC> __device__ __forceinline__ void scan_chunk(const LAS float* buf, int r0, int kq, float (&s)[2][4], float (&n)[2][4], float (&myo)[2]) {
  const LAS float* vb = buf + kq * 4;
#define SCAN_PIN() asm volatile("" : "+v"(myo[0]), "+v"(myo[1]), "+v"(s[0][0]), "+v"(s[1][3]) :: "memory")
#pragma unroll 1
  for (int t = 0; t < 16; t += 4) {
    StepV<NV> A, B; ld_step<NV, SC>(A, vb, buf, t, r0); ld_step<NV, SC>(B, vb, buf, t + 1, r0);
    scan_step<MIX, NV>(A, s, n, myo, kq, t); SCAN_PIN();
    ld_step<NV, SC>(A, vb, buf, t + 2, r0);
    scan_step<MIX, NV>(B, s, n, myo, kq, t + 1); SCAN_PIN();
    ld_step<NV, SC>(B, vb, buf, t + 3, r0);
    scan_step<MIX, NV>(A, s, n, myo, kq, t + 2);
    scan_step<MIX, NV>(B, s, n, myo, kq, t + 3); SCAN_PIN();
  }
#undef SCAN_PIN
}
__device__ __forceinline__ void scan_compute(const LAS float* buf, int mixer, int r0, int kq, float (&s)[2][4], float (&n)[2][4], float (&myo)[2]) {
  if (mixer == 0) scan_chunk<0, 3, false>(buf, r0, kq, s, n, myo);
  else if (mixer == 1) scan_chunk<1, 5, false>(buf, r0, kq, s, n, myo);
  else if (mixer == 2) scan_chunk<2, 2, true>(buf, r0, kq, s, n, myo);
  else scan_chunk<3, 2, true>(buf, r0, kq, s, n, myo);
}

__device__ __forceinline__ void lds_barrier() { asm volatile("s_waitcnt lgkmcnt(0)\n\ts_barrier" ::: "memory"); }
__device__ __forceinline__ void phase_scan(const KP& p, int layer, LAS float* lds) {
  const int tid = otid(), role = __builtin_amdgcn_readfirstlane(tid >> 8), lt = tid & 255;
  const int odd = layer & 1;
  LAS float* hb = lds;
  bf16_t* O = (bf16_t*)(p.ws + OFF_O);
  for (int item = blockIdx.x; item < 256; item += gridDim.x) {
    const int mixer = item >> 6, sub = item & 63;
    const int d = sub >> 5, b = (sub >> 3) & 3, h = (sub >> 1) & 3, rh = sub & 1;
    const int cm = (mixer < 2) ? odd : !odd;
    if (role == 1) {
      float ka[4] = {0.f, 0.f, 0.f, 0.f}, ib = 0.f, fb = 0.f;
      if (mixer == 1) { const float* k_a = p.in[I_RKA] + layer * 256 + h * 64 + (lt & 15) * 4; ka[0] = k_a[0]; ka[1] = k_a[1]; ka[2] = k_a[2]; ka[3] = k_a[3]; }
      if (mixer == 3) { ib = p.in[I_MIB][layer * 8 + d * 4 + h]; fb = p.in[I_MFB][layer * 8 + d * 4 + h]; }
      ScanRegs RA, RB;
      scan_load(RA, mixer, 0, d, b, h, rh, cm, lt, p); scan_load(RB, mixer, 1, d, b, h, rh, cm, lt, p);
      scan_stage(RA, hb, mixer, lt, ka, ib, fb);
      scan_load(RA, mixer, 2, d, b, h, rh, cm, lt, p);
      lds_barrier();
      for (int c = 0; c < NCHUNK; c += 2) {
        scan_stage(RB, hb + SBUF, mixer, lt, ka, ib, fb);
        scan_load(RB, mixer, c + 3, d, b, h, rh, cm, lt, p);
        lds_barrier();
        scan_stage(RA, hb, mixer, lt, ka, ib, fb);
        scan_load(RA, mixer, c + 4, d, b, h, rh, cm, lt, p);
        lds_barrier();
      }
    } else {
      const int kq = lt & 15, r0 = (lt >> 4) * 2;
      float s[2][4], n[2][4];
#pragma unroll
      for (int r = 0; r < 2; ++r)
#pragma unroll
        for (int i = 0; i < 4; ++i) { s[r][i] = 0.f; n[r][i] = 0.f; }
      bf16_t* Od = O + (size_t)d * NTOK * 1024 + mixer * 256 + h * 64 + rh * 32 + r0;
      lds_barrier();
      for (int c = 0; c < NCHUNK; c += 2) {
        { float o[2] = {0.f, 0.f}; scan_compute(hb, mixer, r0, kq, s, n, o);
          *(unsigned*)(Od + (size_t)seq_row(c * 16 + kq, d, b, cm) * 1024) = cvt_pk_bf16(o[0], o[1]); }
        lds_barrier();
        { float o[2] = {0.f, 0.f}; scan_compute(hb + SBUF, mixer, r0, kq, s, n, o);
          *(unsigned*)(Od + (size_t)seq_row((c + 1) * 16 + kq, d, b, cm) * 1024) = cvt_pk_bf16(o[0], o[1]); }
        lds_barrier();
      }
    }
  }
}

#ifndef PH_MASK
#define PH_MASK 0xFFFF
#endif
__global__ void __launch_bounds__(512, 2) mega(KP p) {
  extern __shared__ __attribute__((aligned(16))) unsigned char shm[];
  cg::grid_group grid = cg::this_grid();
  LAS unsigned char* lds = (LAS unsigned char*)shm;
  float* ldsf = (float*)shm;
  const int tid = threadIdx.x, gtid = blockIdx.x * 512 + tid, gsz = gridDim.x * 512;
  float* MOD = (float*)(p.ws + OFF_MOD);
  volatile LAS unsigned* bst = (volatile LAS unsigned*)(lds + pg8::STAGE_BYTES);
  if (tid < 2) bst[tid] = 0u;
  __syncthreads();
  const XcdBarrier xb = xcd_barrier_post((unsigned*)(p.ws + OFF_BAR), bst);

  { const f32x4* xs = (const f32x4*)p.in[I_X]; f32x4* xd = (f32x4*)p.out;
    for (int i = gtid; i < NLAT * DM / 4; i += gsz) xd[i] = xs[i];
    const f32x4* cs = (const f32x4*)p.in[I_CTX]; f32x4* cd = (f32x4*)(p.ws + OFF_XC);
    for (int i = gtid; i < 1024 * DM / 4; i += gsz) cd[i] = cs[i];
    for (int i = tid; i < 5 * 1024; i += 512) { const float cv = i < 4096 ? p.in[I_C][i] : p.in[I_CCTX][i - 4096]; ldsf[i] = siluf_(cv); }
    __syncthreads();
    float* MODP = (float*)(p.ws + OFF_MODP);
    for (int g = gtid; g < NLAYER * 8 * 6144; g += gsz) { const int col = g % 6144, ks = (g / 6144) & 7, l = g / (6144 * 8);
      const float* w = p.in[I_ADAW] + ((size_t)l * 1024 + ks * 128) * 6144 + col; float a[5] = {0.f, 0.f, 0.f, 0.f, 0.f};
      for (int k = 0; k < 128; ++k) { const float wv = w[(size_t)k * 6144];
#pragma unroll
        for (int b = 0; b < 5; ++b) a[b] += ldsf[b * 1024 + ks * 128 + k] * wv; }
#pragma unroll
      for (int b = 0; b < 5; ++b) MODP[(((size_t)ks * NLAYER + l) * 5 + b) * 6144 + col] = a[b]; }
    if (gtid < 512) { const int dc = gtid; const float* gm = p.in[I_HGAMMA]; float e[4], mx = -1e30f, sum = 0.f;
      for (int l = 0; l < 4; ++l) mx = fmaxf(mx, gm[l * 512 + dc]);
      for (int l = 0; l < 4; ++l) { e[l] = __expf(gm[l * 512 + dc] - mx); sum += e[l]; }
      float* LB = (float*)(p.ws + OFF_LB); float cum = 0.f; LB[dc] = 0.f;
      for (int l = 1; l < 4; ++l) { cum += e[l] / sum; LB[l * 512 + dc] = cum; } }
    __syncthreads();
    phase_convert_weights(p, 0, ldsf);
  }
  grid.sync();
  { const float* MODP = (const float*)(p.ws + OFF_MODP);
    for (int i = gtid; i < NLAYER * 5 * 6144; i += gsz) { const int col = i % 6144, l = i / (5 * 6144); float a = p.in[I_ADAB][l * 6144 + col];
#pragma unroll
      for (int ks = 0; ks < 8; ++ks) a += MODP[(size_t)ks * NLAYER * 5 * 6144 + i];
      MOD[i] = a; } }
  xcd_barrier(xb);
  phase_modulate(p, 0);
  xcd_barrier(xb);

  for (int layer = 0; layer < NLAYER; ++layer) {
    const bool lastl = (layer == NLAYER - 1);
    const float* modl = MOD + (size_t)layer * 5 * 6144;
    pg8::StaticOrder S;
    if (PH_MASK & 1) { pg8::Gemm g{(const bf16_t*)(p.ws + OFF_HA), (const bf16_t*)(p.ws + OFF_WIN), NTOK, LDP, 1024, 1024, 1024, 1};
      pg8::EpiB E{(bf16_t*)(p.ws + OFF_P), LDP, 0, (const float*)(p.ws + OFF_LB) + layer * 512, nullptr};
      S.init(g.M, g.N, g.S, gridDim.x, blockIdx.x); pg8::gemm_phase(lds, g, S, E); }
    xcd_barrier(xb);
    if (PH_MASK & 2) phase_prep(p, layer);
    xcd_barrier(xb);
    if (PH_MASK & 4) { pg8::Gemm g{(const bf16_t*)(p.ws + OFF_U), (const bf16_t*)(p.ws + OFF_WC), NTOK, 1280, 384, 384, 384, 1};
      pg8::EpiB E{(bf16_t*)(p.ws + OFF_RP), 2304, 2, p.in[I_RW0] + layer * 512, p.in[I_RA0] + layer * 512};
      S.init(g.M, g.N, g.S, gridDim.x, blockIdx.x); pg8::gemm_phase(lds, g, S, E); }
    xcd_barrier(xb);
    if (PH_MASK & 8) phase_scan(p, layer, (LAS float*)lds);
    xcd_barrier(xb);
    const int nrows = lastl ? NLAT : NTOK;
    if (PH_MASK & 16) phase_finish(p, layer, nrows);
    xcd_barrier(xb);
    { pg8::Gemm g{(const bf16_t*)(p.ws + OFF_YMIX), (const bf16_t*)(p.ws + OFF_WOUT), NLAT, 1024, 1024, 1024, 1024, 1};
      pg8::EpiR E{p.out, (float*)(p.ws + OFF_XC), modl + 2 * 1024};
      S.init(g.M, g.N, g.S, gridDim.x, blockIdx.x); pg8::gemm_phase(lds, g, S, E); }
    if (!lastl) {
      pg8::Gemm g{(const bf16_t*)(p.ws + OFF_YMIX) + (size_t)NLAT * 1024, (const bf16_t*)(p.ws + OFF_WOUT), 1024, 1024, 256, 1024, 1024, 4};
      pg8::EpiP E{(float*)(p.ws + OFF_YC), modl + 4 * 6144 + 2 * 1024};
      S.init(g.M, g.N, g.S, gridDim.x, (blockIdx.x + 128) & 255); pg8::gemm_phase(lds, g, S, E); }
    xcd_barrier(xb);
    phase_ln(p, p.in[I_LN1G] + layer * 1024, p.in[I_LN1B] + layer * 1024, modl, 3 * 1024, nrows);
    xcd_barrier(xb);
    if (PH_MASK & 64) { pg8::Gemm g{(const bf16_t*)(p.ws + OFF_HA), (const bf16_t*)(p.ws + OFF_W1), nrows, DFF, 1024, 1024, 1024, 1};
      pg8::EpiB E{(bf16_t*)(p.ws + OFF_HID), DFF, 1, nullptr, nullptr};
      S.init(g.M, g.N, g.S, gridDim.x, blockIdx.x); pg8::gemm_phase(lds, g, S, E); }
    xcd_barrier(xb);
    { pg8::Gemm g{(const bf16_t*)(p.ws + OFF_HID), (const bf16_t*)(p.ws + OFF_W2), NLAT, 1024, DFF, DFF, DFF, 1};
      pg8::EpiR E{p.out, (float*)(p.ws + OFF_XC), modl + 5 * 1024};
      S.init(g.M, g.N, g.S, gridDim.x, blockIdx.x); pg8::gemm_phase(lds, g, S, E); }
    if (!lastl) {
      pg8::Gemm g{(const bf16_t*)(p.ws + OFF_HID) + (size_t)NLAT * DFF, (const bf16_t*)(p.ws + OFF_W2), 1024, 1024, 1024, DFF, DFF, 4};
      pg8::EpiP E{(float*)(p.ws + OFF_YC), modl + 4 * 6144 + 5 * 1024};
      S.init(g.M, g.N, g.S, gridDim.x, (blockIdx.x + 128) & 255); pg8::gemm_phase(lds, g, S, E); }
    xcd_barrier(xb);
    phase_ln(p, p.in[I_LN2G] + layer * 1024, p.in[I_LN2B] + layer * 1024, lastl ? nullptr : modl + 5 * 6144, 0, nrows);
    if (!lastl) { __syncthreads(); phase_convert_weights(p, layer + 1, ldsf); xcd_barrier(xb); }
  }
}

extern "C" void kernel_launch(void* const* d_in, const int* in_sizes, int n_in, void* d_out, int out_size, void* d_ws, size_t ws_size, hipStream_t stream) {
  constexpr size_t kLds = pg8::STAGE_BYTES + 16;
  static int grid = 0;
  if (!grid) {
    int dev = 0, cus = 0, per_cu = 0;
    hipGetDevice(&dev);
    hipDeviceGetAttribute(&cus, hipDeviceAttributeMultiprocessorCount, dev);
    hipFuncSetAttribute((const void*)mega, hipFuncAttributeMaxDynamicSharedMemorySize, (int)kLds);
    hipOccupancyMaxActiveBlocksPerMultiprocessor(&per_cu, (const void*)mega, 512, kLds);
    if (per_cu < 1) per_cu = 1;
    grid = cus * per_cu;
    if (grid > 256) grid = 256;
    if (ws_size < WS_END2 || n_in != 34) { fprintf(stderr, "kernel_launch: workspace %zu < %zu or n_in %d != 34\n", ws_size, (size_t)WS_END2, n_in); grid = -1; }
  }
  if (grid < 0) return;
  hipMemsetAsync((unsigned char*)d_ws + OFF_BAR, 0, (size_t)XCD_BAR_WORDS * 4, stream);
  KP p{};
  for (int i = 0; i < 34; ++i) p.in[i] = (const float*)d_in[i];
  p.out = (float*)d_out; p.ws = (unsigned char*)d_ws;
  void* args[] = {&p};
  hipError_t e = hipLaunchCooperativeKernel((const void*)mega, dim3(grid), dim3(512), args, kLds, stream);
  if (e != hipSuccess) fprintf(stderr, "cooperative launch failed: %s (grid %d)\n", hipGetErrorString(e), grid);
}
```
